# Optimizing an MI355X kernel written in HIP

```python
import jax, jax.numpy as jnp
from jax import lax
import numpy as np

D_MODEL = 1024
BATCH = 8
SEQ = 2048
DEPTH = 4

GRID_W = 64
CTX_LEN = 256
N_MIXERS = 3
HEAD_DIM = 64
N_HEADS = D_MODEL // HEAD_DIM
MLA_Q_LORA = 3 * D_MODEL // 8
MLA_KV_LORA = D_MODEL // 4
MLA_QK_NOPE = 64
MLA_QK_ROPE = 32
MLA_V_DIM = 64
SWA_KV_HEADS = N_HEADS // 4
SWA_WINDOW = 128
GA_KV_HEADS = N_HEADS // 2
Q_BLOCK = 128
D_FF = ((8 * D_MODEL // 3 + 127) // 128) * 128
N_EXPERTS = 8
TOP_K = 2
EXPERT_FF = D_FF // 2
ROPE_THETA = 10000.0
NORM_EPS = 1e-6
NEG_INF = -1e30

kernel_name = "hybrid_mla_swa_axialgqa_moe_dit"


def _rmsnorm(x, g):
    xf = x.astype(jnp.float32)
    y = xf * lax.rsqrt(jnp.mean(xf * xf, axis=-1, keepdims=True) + NORM_EPS)
    return (y * g.astype(jnp.float32)).astype(x.dtype)


def _modulate(h, shift, scale):
    return h * (1 + scale) + shift


def _axial_rope_tables(rows_n, rot_dim):
    n_freq = rot_dim // 4
    inv = ROPE_THETA ** (-jnp.arange(n_freq, dtype=jnp.float32) / n_freq)
    rows = jnp.broadcast_to(jnp.arange(rows_n, dtype=jnp.float32)[:, None], (rows_n, GRID_W)).reshape(-1)
    cols = jnp.broadcast_to(jnp.arange(GRID_W, dtype=jnp.float32)[None, :], (rows_n, GRID_W)).reshape(-1)
    ang = jnp.concatenate([rows[:, None] * inv, cols[:, None] * inv], axis=-1)
    return jnp.cos(ang), jnp.sin(ang)


def _rope(x, cos, sin):
    half = x.shape[-1] // 2
    xf = x.astype(jnp.float32)
    x1, x2 = xf[..., :half], xf[..., half:]
    cs = cos[None, :, None, :]
    sn = sin[None, :, None, :]
    return jnp.concatenate([x1 * cs - x2 * sn, x2 * cs + x1 * sn], axis=-1).astype(x.dtype)


def _softmax_attend(q, ks, vs, masks, sink):
    scores = []
    for k, m in zip(ks, masks):
        s = jnp.einsum('bqhgd,bkhd->bhgqk', q, k).astype(jnp.float32)
        if m is not None:
            s = jnp.where(m, s, NEG_INF)
        scores.append(s)
    lens = [s.shape[-1] for s in scores]
    if sink is not None:
        sk = sink.astype(jnp.float32)[None, :, :, None, None]
        scores.append(jnp.broadcast_to(sk, scores[0].shape[:-1] + (1,)))
    p = jax.nn.softmax(jnp.concatenate(scores, axis=-1), axis=-1)
    out = 0
    off = 0
    for v, n in zip(vs, lens):
        out = out + jnp.einsum('bhgqk,bkhd->bqhgd', p[..., off:off + n].astype(v.dtype), v)
        off += n
    return out


def _dense_blocks(q, k_l, v_l, k_c, v_c):
    b, s, hkv, g, dk = q.shape
    nb = s // Q_BLOCK
    qb = jnp.moveaxis(q.reshape(b, nb, Q_BLOCK, hkv, g, dk), 1, 0)
    ob = lax.map(lambda qi: _softmax_attend(qi, (k_l, k_c), (v_l, v_c), (None, None), None), qb)
    return jnp.moveaxis(ob, 0, 1).reshape(b, s, hkv, g, -1)


def _window_blocks(q, k_l, v_l, k_c, v_c, sink):
    b, s, hkv, g, dk = q.shape
    nb = s // Q_BLOCK

    def bands(t):
        tp = jnp.pad(t, ((0, 0), (Q_BLOCK, Q_BLOCK), (0, 0), (0, 0))).reshape(b, nb + 2, Q_BLOCK, hkv, -1)
        band = jnp.concatenate([tp[:, :-2], tp[:, 1:-1], tp[:, 2:]], axis=2)
        return jnp.moveaxis(band, 1, 0)

    qpos = jnp.arange(s).reshape(nb, Q_BLOCK)
    kpos = jnp.arange(nb)[:, None] * Q_BLOCK - Q_BLOCK + jnp.arange(3 * Q_BLOCK)[None, :]
    inside = (kpos >= 0) & (kpos < s)
    valid = (jnp.abs(qpos[:, :, None] - kpos[:, None, :]) <= SWA_WINDOW) & inside[:, None, :]
    qb = jnp.moveaxis(q.reshape(b, nb, Q_BLOCK, hkv, g, dk), 1, 0)
    ob = lax.map(lambda a: _softmax_attend(a[0], (a[1], k_c), (a[2], v_c), (a[3], None), sink),
                 (qb, bands(k_l), bands(v_l), valid))
    return jnp.moveaxis(ob, 0, 1).reshape(b, s, hkv, g, -1)


def _mla(h_l, h_c, w_dq, q_norm_g, w_uq, w_dkv, kv_norm_g, w_ukv, w_o, cos, sin, need_ctx):
    def project(h, rotate):
        b, l, _ = h.shape
        q = (_rmsnorm(h @ w_dq, q_norm_g) @ w_uq).reshape(b, l, N_HEADS, MLA_QK_NOPE + MLA_QK_ROPE)
        q_nope, q_rope = q[..., :MLA_QK_NOPE], q[..., MLA_QK_NOPE:]
        kv_a = h @ w_dkv
        c_kv = _rmsnorm(kv_a[..., :MLA_KV_LORA], kv_norm_g)
        k_rope = kv_a[..., MLA_KV_LORA:][:, :, None, :]
        if rotate:
            q_rope = _rope(q_rope, cos, sin)
            k_rope = _rope(k_rope, cos, sin)
        kv = (c_kv @ w_ukv).reshape(b, l, N_HEADS, MLA_QK_NOPE + MLA_V_DIM)
        k = jnp.concatenate([kv[..., :MLA_QK_NOPE],
                             jnp.broadcast_to(k_rope, (b, l, N_HEADS, MLA_QK_ROPE))], axis=-1)
        v = kv[..., MLA_QK_NOPE:]
        q = jnp.concatenate([q_nope, q_rope], axis=-1) * (MLA_QK_NOPE + MLA_QK_ROPE) ** -0.5
        return q[:, :, :, None, :], k, v

    b, s, _ = h_l.shape
    q_l, k_l, v_l = project(h_l, True)
    q_c, k_c, v_c = project(h_c, False)
    y_l = _dense_blocks(q_l, k_l, v_l, k_c, v_c).reshape(b, s, -1) @ w_o
    y_c = None
    if need_ctx:
        o_c = _softmax_attend(q_c, (k_c,), (v_c,), (None,), None)
        y_c = o_c.reshape(b, h_c.shape[1], -1) @ w_o
    return y_l, y_c


def _gqa_project(h, w_qkv, n_kv, q_norm_g, k_norm_g, cos, sin, rotate):
    b, l, _ = h.shape
    nq = N_HEADS * HEAD_DIM
    nk = n_kv * HEAD_DIM
    qkv = h @ w_qkv
    q = qkv[..., :nq].reshape(b, l, N_HEADS, HEAD_DIM)
    k = qkv[..., nq:nq + nk].reshape(b, l, n_kv, HEAD_DIM)
    v = qkv[..., nq + nk:].reshape(b, l, n_kv, HEAD_DIM)
    if q_norm_g is not None:
        q = _rmsnorm(q, q_norm_g)
        k = _rmsnorm(k, k_norm_g)
    if rotate:
        q = _rope(q, cos, sin)
        k = _rope(k, cos, sin)
    q = (q * HEAD_DIM ** -0.5).reshape(b, l, n_kv, N_HEADS // n_kv, HEAD_DIM)
    return q, k, v


def _swa(h_l, h_c, w_qkv, sinks, w_o, cos, sin, need_ctx):
    b, s, _ = h_l.shape
    sink = sinks.reshape(SWA_KV_HEADS, N_HEADS // SWA_KV_HEADS)
    q_l, k_l, v_l = _gqa_project(h_l, w_qkv, SWA_KV_HEADS, None, None, cos, sin, True)
    q_c, k_c, v_c = _gqa_project(h_c, w_qkv, SWA_KV_HEADS, None, None, cos, sin, False)
    y_l = _window_blocks(q_l, k_l, v_l, k_c, v_c, sink).reshape(b, s, -1) @ w_o
    y_c = None
    if need_ctx:
        o_c = _softmax_attend(q_c, (k_c,), (v_c,), (None,), sink)
        y_c = o_c.reshape(b, h_c.shape[1], -1) @ w_o
    return y_l, y_c


def _axial_gqa(h_l, h_c, w_qkv, q_norm_g, k_norm_g, w_o, cos, sin, need_ctx):
    b, s, _ = h_l.shape
    q_l, k_l, v_l = _gqa_project(h_l, w_qkv, GA_KV_HEADS, q_norm_g, k_norm_g, cos, sin, True)
    q_c, k_c, v_c = _gqa_project(h_c, w_qkv, GA_KV_HEADS, q_norm_g, k_norm_g, cos, sin, False)
    y_l = _dense_blocks(q_l, k_l, v_l, k_c, v_c).reshape(b, s, -1) @ w_o
    y_c = None
    if need_ctx:
        o_c = _softmax_attend(q_c, (k_c,), (v_c,), (None,), None)
        y_c = o_c.reshape(b, h_c.shape[1], -1) @ w_o
    return y_l, y_c


def _swiglu(t, w_gate_up, w_down):
    gu = t @ w_gate_up
    f = w_down.shape[0]
    return (jax.nn.silu(gu[..., :f]) * gu[..., f:]) @ w_down


def _moe(t, router_w, router_b, w_gate_up, w_down):
    logits = (t @ router_w).astype(jnp.float32) + router_b.astype(jnp.float32)
    top_v, top_i = lax.top_k(logits, TOP_K)
    gates = jax.nn.softmax(top_v, axis=-1)
    combine = jnp.sum(jax.nn.one_hot(top_i, N_EXPERTS, dtype=jnp.float32) * gates[..., None], axis=-2)
    y = jnp.zeros_like(t)
    for e in range(N_EXPERTS):
        y = y + combine[:, e:e + 1].astype(t.dtype) * _swiglu(t, w_gate_up[e], w_down[e])
    return y


def setup_inputs(seed: int = 0) -> dict:
    key = jax.random.key(seed)
    ks = iter(jax.random.split(key, 40))
    n_a = len(range(0, DEPTH, N_MIXERS))
    n_b = len(range(1, DEPTH, N_MIXERS))
    n_c = len(range(2, DEPTH, N_MIXERS))
    n_dense = len(range(0, DEPTH, 2))
    n_moe = len(range(1, DEPTH, 2))
    d = D_MODEL
    attn = N_HEADS * HEAD_DIM

    def rn(shape, std=1.0):
        return jax.random.normal(next(ks), shape, jnp.float32) * std

    def w(shape, fan_in, gain=1.0):
        return rn(shape, gain * fan_in ** -0.5)

    def g(shape):
        return 1.0 + rn(shape, 0.05)

    return {
        "x": rn((BATCH, SEQ, d)),
        "c": rn((BATCH, d)),
        "ctx": rn((BATCH, CTX_LEN, d)),
        "c_ctx": rn((d,)),
        "ada_w": w((DEPTH, d, 6 * d), d, 0.5),
        "ada_b": rn((DEPTH, 6 * d), 0.02),
        "norm_g": g((DEPTH, 2, d)),
        "final_norm_g": g((d,)),
        "mla_w_dq": w((n_a, d, MLA_Q_LORA), d),
        "mla_q_norm_g": g((n_a, MLA_Q_LORA)),
        "mla_w_uq": w((n_a, MLA_Q_LORA, N_HEADS * (MLA_QK_NOPE + MLA_QK_ROPE)), MLA_Q_LORA),
        "mla_w_dkv": w((n_a, d, MLA_KV_LORA + MLA_QK_ROPE), d),
        "mla_kv_norm_g": g((n_a, MLA_KV_LORA)),
        "mla_w_ukv": w((n_a, MLA_KV_LORA, N_HEADS * (MLA_QK_NOPE + MLA_V_DIM)), MLA_KV_LORA),
        "mla_w_o": w((n_a, N_HEADS * MLA_V_DIM, d), N_HEADS * MLA_V_DIM),
        "swa_w_qkv": w((n_b, d, (N_HEADS + 2 * SWA_KV_HEADS) * HEAD_DIM), d),
        "swa_sinks": rn((n_b, N_HEADS), 0.5),
        "swa_w_o": w((n_b, attn, d), attn),
        "ga_w_qkv": w((n_c, d, (N_HEADS + 2 * GA_KV_HEADS) * HEAD_DIM), d),
        "ga_q_norm_g": g((n_c, HEAD_DIM)),
        "ga_k_norm_g": g((n_c, HEAD_DIM)),
        "ga_w_o": w((n_c, attn, d), attn),
        "ffn_w_gate_up": w((n_dense, d, 2 * D_FF), d),
        "ffn_w_down": w((n_dense, D_FF, d), D_FF),
        "moe_router_w": w((n_moe, d, N_EXPERTS), d),
        "moe_router_b": rn((n_moe, N_EXPERTS), 0.01),
        "moe_w_gate_up": w((n_moe, N_EXPERTS, d, 2 * EXPERT_FF), d),
        "moe_w_down": w((n_moe, N_EXPERTS, EXPERT_FF, d), EXPERT_FF),
    }


def reference(x, c, ctx, c_ctx, ada_w, ada_b, norm_g, final_norm_g,
              mla_w_dq, mla_q_norm_g, mla_w_uq, mla_w_dkv, mla_kv_norm_g, mla_w_ukv, mla_w_o,
              swa_w_qkv, swa_sinks, swa_w_o,
              ga_w_qkv, ga_q_norm_g, ga_k_norm_g, ga_w_o,
              ffn_w_gate_up, ffn_w_down,
              moe_router_w, moe_router_b, moe_w_gate_up, moe_w_down):
    b, s, d = x.shape
    n_lat = b * s
    rows_n = s // GRID_W
    cos_mla, sin_mla = _axial_rope_tables(rows_n, MLA_QK_ROPE)
    cos_h, sin_h = _axial_rope_tables(rows_n, HEAD_DIM)
    sc = jax.nn.silu(c)
    scc = jax.nn.silu(c_ctx)

    for i in range(DEPTH):
        need_ctx = i < DEPTH - 1
        mod_l = (sc @ ada_w[i] + ada_b[i]).reshape(b, 6, 1, d)
        mod_c = (scc @ ada_w[i] + ada_b[i]).reshape(6, d)

        h_l = _modulate(_rmsnorm(x, norm_g[i, 0]), mod_l[:, 0], mod_l[:, 1])
        h_c = _modulate(_rmsnorm(ctx, norm_g[i, 0]), mod_c[0], mod_c[1])
        kind, j = i % N_MIXERS, i // N_MIXERS
        if kind == 0:
            y_l, y_c = _mla(h_l, h_c, mla_w_dq[j], mla_q_norm_g[j], mla_w_uq[j], mla_w_dkv[j],
                            mla_kv_norm_g[j], mla_w_ukv[j], mla_w_o[j], cos_mla, sin_mla, need_ctx)
        elif kind == 1:
            y_l, y_c = _swa(h_l, h_c, swa_w_qkv[j], swa_sinks[j], swa_w_o[j], cos_h, sin_h, need_ctx)
        else:
            y_l, y_c = _axial_gqa(h_l, h_c, ga_w_qkv[j], ga_q_norm_g[j], ga_k_norm_g[j], ga_w_o[j],
                                  cos_h, sin_h, need_ctx)
        x = x + mod_l[:, 2] * y_l
        if need_ctx:
            ctx = ctx + mod_c[2] * y_c

        h_l = _modulate(_rmsnorm(x, norm_g[i, 1]), mod_l[:, 3], mod_l[:, 4])
        tokens = h_l.reshape(n_lat, d)
        if need_ctx:
            h_c = _modulate(_rmsnorm(ctx, norm_g[i, 1]), mod_c[3], mod_c[4])
            tokens = jnp.concatenate([tokens, h_c.reshape(-1, d)], axis=0)
        f = i // 2
        if i % 2 == 0:
            out = _swiglu(tokens, ffn_w_gate_up[f], ffn_w_down[f])
        else:
            out = _moe(tokens, moe_router_w[f], moe_router_b[f], moe_w_gate_up[f], moe_w_down[f])
        x = x + mod_l[:, 5] * out[:n_lat].reshape(b, s, d)
        if need_ctx:
            ctx = ctx + mod_c[5] * out[n_lat:].reshape(ctx.shape)

    return _rmsnorm(x, final_norm_g)
```

```cpp
#include <hip/hip_runtime.h>
#include <cstdio>
#include <cstdint>

#define GAS __attribute__((address_space(1)))
#define LAS __attribute__((address_space(3)))
typedef unsigned short bf16;
typedef short bf16x8 __attribute__((ext_vector_type(8)));
typedef short s16x4 __attribute__((ext_vector_type(4)));
typedef float f32x4 __attribute__((ext_vector_type(4)));
typedef float f32x2 __attribute__((ext_vector_type(2)));
typedef float f32x16 __attribute__((ext_vector_type(16)));
typedef unsigned u32x4 __attribute__((ext_vector_type(4)));
typedef unsigned u32x2 __attribute__((ext_vector_type(2)));
typedef int i32x4 __attribute__((ext_vector_type(4)));
typedef GAS unsigned gu32;

#ifndef MK_SPLIT
#define MK_SPLIT 1
#endif

constexpr int NB = 8, SEQ = 2048, CTXL = 256, DM = 1024, RPB = SEQ + CTXL  , T = NB * RPB  , NPAN = T / 256  ;
constexpr int NHEAD = 16, FF = 2816, EFF = 1408, NEXP = 8;
constexpr int MAXR = 2 * T + NEXP * 256;
constexpr float LOG2E = 1.4426950408889634f;
constexpr float NORM_EPS = 1e-6f;
constexpr float QS64 = 0.125f * LOG2E;
constexpr float QS96 = 0.10206207261596577f * LOG2E;

enum { I_X = 0, I_C, I_CTX, I_CCTX, I_ADAW, I_ADAB, I_NORMG, I_FNORMG, I_MLA_DQ, I_MLA_QNG, I_MLA_UQ, I_MLA_DKV, I_MLA_KVNG, I_MLA_UKV, I_MLA_O,
       I_SWA_QKV, I_SWA_SINK, I_SWA_O, I_GA_QKV, I_GA_QNG, I_GA_KNG, I_GA_O, I_FFN_GU, I_FFN_DN, I_MOE_RW, I_MOE_RB, I_MOE_GU, I_MOE_DN, N_IN };

constexpr size_t WSZ_D = 768 * 1024, WSZ_UQ = 1536 * 384, WSZ_UKV = 2048 * 256, WSZ_O = 1024 * 1024;
constexpr size_t MLA_SZ = WSZ_D + WSZ_UQ + WSZ_UKV + WSZ_O;
constexpr size_t W_MLA_D(int j) { return j * MLA_SZ; }
constexpr size_t W_MLA_UQ(int j) { return j * MLA_SZ + WSZ_D; }
constexpr size_t W_MLA_UKV(int j) { return j * MLA_SZ + WSZ_D + WSZ_UQ; }
constexpr size_t W_MLA_O(int j) { return j * MLA_SZ + WSZ_D + WSZ_UQ + WSZ_UKV; }
constexpr size_t W_SWA_QKV = 2 * MLA_SZ, W_SWA_O = W_SWA_QKV + 1536 * 1024;
constexpr size_t W_GA_QKV = W_SWA_O + WSZ_O, W_GA_O = W_GA_QKV + 2048 * 1024;
constexpr size_t W_FFN0 = W_GA_O + WSZ_O, FFN_GU_SZ = (size_t)2 * FF * 1024, FFN_DN_SZ = (size_t)1024 * FF, FFN_SZ = FFN_GU_SZ + FFN_DN_SZ;
constexpr size_t W_FFN_GU(int f) { return W_FFN0 + f * FFN_SZ; }
constexpr size_t W_FFN_DN(int f) { return W_FFN0 + f * FFN_SZ + FFN_GU_SZ; }
constexpr size_t W_MOE0 = W_FFN0 + 2 * FFN_SZ, MOE_GU_SZ = (size_t)2 * EFF * 1024, MOE_DN_SZ = (size_t)1024 * EFF, MOE_SZ = NEXP * (MOE_GU_SZ + MOE_DN_SZ);
constexpr size_t W_MOE_GU(int f) { return W_MOE0 + f * MOE_SZ; }
constexpr size_t W_MOE_DN(int f) { return W_MOE0 + f * MOE_SZ + NEXP * MOE_GU_SZ; }
constexpr size_t W_TOTAL = W_MOE0 + 2 * MOE_SZ;
static_assert(W_TOTAL == 98172928, "weight map");

constexpr size_t MiB = 1u << 20;
constexpr size_t WS_CTL = 0, CTL_ZERO_BYTES = 1 * MiB;
constexpr size_t WS_MOD = 1 * MiB;
constexpr size_t WS_LIST = 2 * MiB;
constexpr size_t WS_INFO = 4 * MiB;
constexpr size_t WS_W = 8 * MiB;
constexpr size_t WS_X = 200 * MiB;
constexpr size_t WS_H = 272 * MiB;
constexpr size_t WS_O = 308 * MiB;
constexpr size_t WS_S = 344 * MiB;
constexpr size_t WS_END = 528 * MiB;
static_assert(WS_W + W_TOTAL * 2 <= WS_X, "weights fit");
constexpr size_t S_QKV = 0;
constexpr size_t S_DOWN = 0;
constexpr size_t S_QN = 27 * MiB;
constexpr size_t S_CKV = 41 * MiB;
constexpr size_t S_KR = 50 * MiB;
constexpr size_t S_QM = 52 * MiB;
constexpr size_t S_KVM = 106 * MiB;
constexpr size_t S_HH = 0;
constexpr size_t S_HS = 0;
constexpr size_t S_YS = 106 * MiB;
static_assert(S_KVM + (size_t)T * 2048 * 2 <= WS_END - WS_S && S_YS + (size_t)MAXR * 1024 * 2 <= WS_END - WS_S && (size_t)MAXR * EFF * 2 <= S_YS, "scratch map");
constexpr int CW_TMO = 0, CW_CODE = 1;
constexpr int CW_BAR = 4096;
constexpr int CW_CNT = 16384;

constexpr int RING_OFF = 0, RING_BYTES = 131072;
constexpr int MISC_OFF = RING_BYTES;
constexpr int LDS_BYTES = 147456;
constexpr int MW_CNT = 32, MW_OFF = 40, MW_NP = 48, MW_TAB = 64;

#define RLX_AGENT __ATOMIC_RELAXED, __HIP_MEMORY_SCOPE_AGENT
#define LDS_WAIT() asm volatile("s_waitcnt lgkmcnt(0)" ::: "memory")
#define VM_WAIT() asm volatile("s_waitcnt vmcnt(0)" ::: "memory")
__device__ __forceinline__ unsigned cvt_pk_bf16(float lo, float hi) { unsigned r; asm volatile("v_cvt_pk_bf16_f32 %0, %1, %2" : "=v"(r) : "v"(lo), "v"(hi)); return r; }
__device__ __forceinline__ float bf_lo(unsigned u) { return __uint_as_float(u << 16); }
__device__ __forceinline__ float bf_hi(unsigned u) { return __uint_as_float(u & 0xffff0000u); }
__device__ __forceinline__ float wave_sum(float v) {
#pragma unroll
    for (int o = 1; o < 64; o <<= 1) v += __shfl_xor(v, o);
    return v;
}
__device__ __forceinline__ float fast_exp2(float x) { return __builtin_amdgcn_exp2f(x); }
__device__ __forceinline__ float fast_rcp(float x) { return __builtin_amdgcn_rcpf(x); }
__device__ __forceinline__ void sincos_rad(float a, float& s, float& c) { float r = a * 0.15915494309189535f; r = r - floorf(r); s = __builtin_amdgcn_sinf(r); c = __builtin_amdgcn_cosf(r); }

namespace pg8 {
constexpr int BM = 256, BK = 64, HALF = 128, HTB = HALF * BK * 2, STAGE_BYTES = 8 * HTB, NXCD = 8, WGM = 8;
__host__ __device__ __forceinline__ int lds_byte(int r, int c) { const int st = (r >> 4) * 2 + (c >> 5), rr = r & 15, cc = c & 31, ob = rr * 64 + cc * 2; return st * 1024 + (ob ^ (((ob >> 9) & 1) << 5)); }
__host__ __device__ __forceinline__ void stage_rc(int b, int& R, int& C) { const int st = b / 1024, sb = b % 1024, swz = sb ^ (((sb >> 9) & 1) << 5); R = (st >> 1) * 16 + swz / 64; C = (st & 1) * 32 + (swz % 64) / 2; }
__host__ __device__ __forceinline__ int perm32(int rho) { const int n = rho >> 4, i = rho & 15; return 8 * (i >> 2) + 4 * n + (i & 3); }

struct Unit { int pm, pn, arow, eb, nvalid; const int* list; };
struct Gemm { const bf16* A; const bf16* Bt; int N, K; };

struct DenseOrder {
    int nM, nN, nwg, G, c, lat;
    __device__ __forceinline__ void init(int nM_, int nN_, int G_, int c_, int lat_) { nM = nM_; nN = nN_; nwg = nM * nN; G = G_; c = c_; lat = lat_; }
    __device__ __forceinline__ bool next(int i, Unit& u) const {
        const long L = (long)i * G + c; if (L >= nwg) return false;
        int wgid = (int)L; { const int q = nwg / NXCD, r = nwg % NXCD, xcd = wgid % NXCD, off = wgid / NXCD; wgid = (xcd < r ? xcd * (q + 1) : r * (q + 1) + (xcd - r) * q) + off; }
        const int nig = WGM * nN, gid = wgid / nig, fm = gid * WGM, gsz = (nM - fm) < WGM ? (nM - fm) : WGM;
        int pm = fm + ((wgid % nig) % gsz); u.pn = (wgid % nig) / gsz;
        if (lat) pm = (pm >> 3) * 9 + 1 + (pm & 7);
        u.pm = pm; u.arow = pm * BM; u.eb = 0; u.nvalid = BM; u.list = nullptr; return true;
    }
};
struct MoeOrder {
    volatile LAS unsigned* misc; const int* lists; int nN, G, c, gather;
    __device__ __forceinline__ bool next(int i, Unit& u) const {
        const int NP = __builtin_amdgcn_readfirstlane((int)misc[MW_NP]); const long L = (long)i * G + c; if (L >= (long)NP * nN) return false;
        const int p = (int)(L / nN); u.pn = (int)(L % nN);
        const unsigned tv = (unsigned)__builtin_amdgcn_readfirstlane((int)misc[MW_TAB + p]); const int e = (int)(tv >> 16), lp = (int)(tv & 0xffffu);
        u.pm = p; u.arow = p * BM; u.eb = e; u.nvalid = __builtin_amdgcn_readfirstlane((int)misc[MW_CNT + e]) - lp * BM; u.list = lists + (size_t)e * T + lp * BM; return true;
    }
};

struct EpiBf16 {
    static constexpr bool PERM = true;
    bf16* O; int ldc;
    __device__ __forceinline__ void operator()(const f32x4 (&acc)[2][2][4][2], const Unit& u, int wr, int wc, int fr, int fq) const {
        const int row0 = u.pm * BM + wr * 64 + fr; const int col0 = u.pn * BM + wc * 32 + 8 * fq;
#pragma unroll
        for (int ai = 0; ai < 2; ++ai)
#pragma unroll
            for (int m = 0; m < 4; ++m) { bf16* rowp = O + (size_t)(row0 + ai * HALF + m * 16) * ldc + col0;
#pragma unroll
                for (int bj = 0; bj < 2; ++bj) { const f32x4 v0 = acc[ai][bj][m][0], v1 = acc[ai][bj][m][1];
                    u32x4 w; w.x = cvt_pk_bf16(v0[0], v0[1]); w.y = cvt_pk_bf16(v0[2], v0[3]); w.z = cvt_pk_bf16(v1[0], v1[1]); w.w = cvt_pk_bf16(v1[2], v1[3]);
                    *(u32x4*)(rowp + bj * HALF) = w; } }
    }
};
struct EpiSwiglu {
    static constexpr bool PERM = true;
    bf16* O; int ldc;
    __device__ __forceinline__ void operator()(const f32x4 (&acc)[2][2][4][2], const Unit& u, int wr, int wc, int fr, int fq) const {
        const int row0 = u.pm * BM + wr * 64 + fr; const int col0 = u.pn * HALF + wc * 32 + 8 * fq;
#pragma unroll
        for (int ai = 0; ai < 2; ++ai)
#pragma unroll
            for (int m = 0; m < 4; ++m) { bf16* rowp = O + (size_t)(row0 + ai * HALF + m * 16) * ldc + col0; float o[8];
#pragma unroll
                for (int n = 0; n < 2; ++n)
#pragma unroll
                    for (int e = 0; e < 4; ++e) { const float g = acc[ai][0][m][n][e], up = acc[ai][1][m][n][e];
                        o[n * 4 + e] = g * up * fast_rcp(1.0f + fast_exp2(-g * LOG2E)); }
                u32x4 w; w.x = cvt_pk_bf16(o[0], o[1]); w.y = cvt_pk_bf16(o[2], o[3]); w.z = cvt_pk_bf16(o[4], o[5]); w.w = cvt_pk_bf16(o[6], o[7]);
                *(u32x4*)rowp = w; }
    }
};
struct EpiResid {
    static constexpr bool PERM = false;
    float* X; const float* gates;
    __device__ __forceinline__ void operator()(const f32x4 (&acc)[2][2][4][2], const Unit& u, int wr, int wc, int fr, int fq) const {
        const int b = u.pm / 9, mi = (u.pm - b * 9 == 0) ? 8 : b;
        const int col0 = u.pn * BM + wc * 32 + 4 * fq; const float* gp = gates + (size_t)mi * 6144 + col0;
        f32x4 gv[2][2];
#pragma unroll
        for (int bj = 0; bj < 2; ++bj)
#pragma unroll
            for (int n = 0; n < 2; ++n) gv[bj][n] = *(const f32x4*)(gp + bj * HALF + n * 16);
#pragma unroll
        for (int ai = 0; ai < 2; ++ai)
#pragma unroll
            for (int m = 0; m < 4; ++m) { float* rowp = X + (size_t)(u.pm * BM + ai * HALF + wr * 64 + m * 16 + fr) * DM + col0;
#pragma unroll
                for (int bj = 0; bj < 2; ++bj)
#pragma unroll
                    for (int n = 0; n < 2; ++n) { f32x4* p = (f32x4*)(rowp + bj * HALF + n * 16); const f32x4 xv = *p; *p = xv + gv[bj][n] * acc[ai][bj][m][n]; }
                if (m & 1) asm volatile("" ::: "memory"); }
    }
};

template <class Epi, class Sched, bool GATHER>
__device__ __forceinline__ void gemm_phase(LAS unsigned char* lds, const Gemm g, const Sched& S, const Epi& E) {
    const int tid = threadIdx.x, wid = __builtin_amdgcn_readfirstlane(tid >> 6), lane = tid & 63, wr = wid >> 2, wc = wid & 3, fr = lane & 15, fq = lane >> 4;
    const int K = g.K, nt = K / BK;
    unsigned voffB[2], c2[2]; int rr[2];
#pragma unroll
    for (int i = 0; i < 2; ++i) { int R, C; stage_rc(tid * 16 + i * 8192, R, C); const int Rb = Epi::PERM ? ((R & ~31) + perm32(R & 31)) : R;
        voffB[i] = (unsigned)(Rb * K + C) * 2u; rr[i] = R; c2[i] = (unsigned)C * 2u; }
    const size_t kstep = (size_t)(BK * 2);
    const size_t hstep = (size_t)HALF * K * 2;
    const unsigned ldsw = (unsigned)wid * 1024u;
    const int aoff = lds_byte(wr * 64 + fr, fq * 8), boff = lds_byte(wc * 32 + fr, fq * 8);
    unsigned vAc[2][2], vAn[2][2];
#define PG8_SA(b, h) (((b) * 2 + (h)) * HTB)
#define PG8_SB(b, h) ((4 + (b) * 2 + (h)) * HTB)
#define PG8_STAGE_B(bufoff, gbase) do { _Pragma("unroll") for (int _i = 0; _i < 2; ++_i) \
        __builtin_amdgcn_global_load_lds((const unsigned*)((const char*)(gbase) + voffB[_i]), (LAS unsigned*)(lds + (bufoff) + ldsw + _i * 8192), 16, 0, 0); } while (0)
#define PG8_STAGE_A(bufoff, gbase, V, h) do { _Pragma("unroll") for (int _i = 0; _i < 2; ++_i) \
        __builtin_amdgcn_global_load_lds((const unsigned*)((const char*)(gbase) + (V)[h][_i]), (LAS unsigned*)(lds + (bufoff) + ldsw + _i * 8192), 16, 0, 0); } while (0)
#define PG8_LDA(dst, b, h) do { _Pragma("unroll") for (int m = 0; m < 4; ++m) _Pragma("unroll") for (int k = 0; k < 2; ++k) dst[m][k] = *(const LAS bf16x8*)(lds + PG8_SA(b, h) + aoff + m * 2048 + k * 1024); } while (0)
#define PG8_LDB(dst, b, h) do { _Pragma("unroll") for (int n = 0; n < 2; ++n) _Pragma("unroll") for (int k = 0; k < 2; ++k) dst[n][k] = *(const LAS bf16x8*)(lds + PG8_SB(b, h) + boff + n * 2048 + k * 1024); } while (0)
#define PG8_MMA(ai, bj, At, Bt) do { __builtin_amdgcn_s_setprio(1); _Pragma("unroll") for (int m = 0; m < 4; ++m) _Pragma("unroll") for (int n = 0; n < 2; ++n) _Pragma("unroll") for (int k = 0; k < 2; ++k) \
        acc[ai][bj][m][n] = __builtin_amdgcn_mfma_f32_16x16x32_bf16(Bt[n][k], At[m][k], acc[ai][bj][m][n], 0, 0, 0); __builtin_amdgcn_s_setprio(0); } while (0)
#define PG8_WAIT_V(n) asm volatile("s_waitcnt vmcnt(" #n ")" ::: "memory")
#define PG8_WAIT_L(n) asm volatile("s_waitcnt lgkmcnt(" #n ")" ::: "memory")
#define PG8_BAR __builtin_amdgcn_s_barrier()
#define PG8_SCHED __builtin_amdgcn_sched_barrier(0)
#define PG8_SETV(V, U) do { _Pragma("unroll") for (int _h = 0; _h < 2; ++_h) _Pragma("unroll") for (int _i = 0; _i < 2; ++_i) { \
        if constexpr (GATHER) { const int _r = _h * HALF + rr[_i]; const int _tok = (_r < (U).nvalid) ? (U).list[_r] : 0; (V)[_h][_i] = (unsigned)_tok * (unsigned)(K * 2) + c2[_i]; } \
        else (V)[_h][_i] = (unsigned)((_h * HALF + rr[_i]) * K) * 2u + c2[_i]; } } while (0)
    Unit cur, nxt; int ui = 0;
    if (!S.next(0, cur)) return;
    f32x4 acc[2][2][4][2];
#pragma unroll
    for (int a = 0; a < 2; ++a)
#pragma unroll
        for (int b = 0; b < 2; ++b)
#pragma unroll
            for (int m = 0; m < 4; ++m)
#pragma unroll
                for (int n = 0; n < 2; ++n) acc[a][b][m][n] = (f32x4){0.f, 0.f, 0.f, 0.f};
    bf16x8 At[4][2], B0[2][2], B1[2][2];
    PG8_SETV(vAc, cur);
    const char* cA = (const char*)g.A + (GATHER ? (size_t)0 : (size_t)cur.arow * K * 2);
    const char* cB = (const char*)g.Bt + ((size_t)cur.eb * g.N + (size_t)cur.pn * BM) * K * 2;
    PG8_STAGE_B(PG8_SB(0, 0), cB); PG8_STAGE_B(PG8_SB(0, 1), cB + hstep); PG8_STAGE_A(PG8_SA(0, 0), cA, vAc, 0); PG8_STAGE_A(PG8_SA(0, 1), cA, vAc, 1);
    if (wr == 1) PG8_BAR;
    PG8_WAIT_V(2); PG8_BAR;
    PG8_STAGE_B(PG8_SB(1, 0), cB + kstep); PG8_STAGE_A(PG8_SA(1, 0), cA + kstep, vAc, 0); PG8_STAGE_B(PG8_SB(1, 1), cB + hstep + kstep);
    PG8_WAIT_V(6); PG8_BAR;
    for (;;) {
        const bool has_next = S.next(ui + 1, nxt);
        const char* nA = cA; const char* nB = cB;
        if (has_next) { nA = (const char*)g.A + (GATHER ? (size_t)0 : (size_t)nxt.arow * K * 2); nB = (const char*)g.Bt + ((size_t)nxt.eb * g.N + (size_t)nxt.pn * BM) * K * 2; }
        if constexpr (GATHER) { if (has_next) PG8_SETV(vAn, nxt); else { _Pragma("unroll") for (int _h = 0; _h < 2; ++_h) _Pragma("unroll") for (int _i = 0; _i < 2; ++_i) vAn[_h][_i] = vAc[_h][_i]; } }
        for (int t = 0; t < nt; t += 2) {
            const bool last = (t == nt - 2);
            const char* a1 = cA + (size_t)(t + 1) * kstep;
            const char* a2 = last ? nA : cA + (size_t)(t + 2) * kstep; const char* b2 = last ? nB : cB + (size_t)(t + 2) * kstep;
            const char* a3 = a2 + kstep; const char* b3 = b2 + kstep;
            unsigned v2[2][2];
#pragma unroll
            for (int _h = 0; _h < 2; ++_h)
#pragma unroll
                for (int _i = 0; _i < 2; ++_i) v2[_h][_i] = (GATHER && last) ? vAn[_h][_i] : vAc[_h][_i];
            PG8_LDB(B0, 0, 0); PG8_LDB(B1, 0, 1); PG8_SCHED; PG8_LDA(At, 0, 0); PG8_STAGE_A(PG8_SA(1, 1), a1, vAc, 1);
            PG8_WAIT_V(8); PG8_WAIT_L(0); PG8_BAR; PG8_MMA(0, 0, At, B0); PG8_MMA(0, 1, At, B1); PG8_BAR; PG8_SCHED;
            PG8_LDA(At, 0, 1); PG8_STAGE_B(PG8_SB(0, 0), b2); PG8_STAGE_B(PG8_SB(0, 1), b2 + hstep); PG8_STAGE_A(PG8_SA(0, 0), a2, v2, 0);
            PG8_WAIT_V(8); PG8_WAIT_L(0); PG8_BAR; PG8_MMA(1, 0, At, B0); PG8_MMA(1, 1, At, B1); PG8_BAR; PG8_SCHED;
            PG8_LDB(B0, 1, 0); PG8_LDB(B1, 1, 1); PG8_SCHED; PG8_LDA(At, 1, 0); PG8_STAGE_A(PG8_SA(0, 1), a2, v2, 1);
            PG8_WAIT_V(8); PG8_WAIT_L(0); PG8_BAR; PG8_MMA(0, 0, At, B0); PG8_MMA(0, 1, At, B1); PG8_BAR; PG8_SCHED;
            PG8_LDA(At, 1, 1); PG8_STAGE_B(PG8_SB(1, 0), b3); PG8_STAGE_B(PG8_SB(1, 1), b3 + hstep); PG8_STAGE_A(PG8_SA(1, 0), a3, v2, 0);
            PG8_WAIT_V(8); PG8_WAIT_L(0); PG8_BAR; PG8_MMA(1, 0, At, B0); PG8_MMA(1, 1, At, B1); PG8_BAR; PG8_SCHED;
        }
        if (wr == 0) PG8_BAR;
        E(acc, cur, wr, wc, fr, fq);
        if (!has_next) break;
#pragma unroll
        for (int a = 0; a < 2; ++a)
#pragma unroll
            for (int b = 0; b < 2; ++b)
#pragma unroll
                for (int m = 0; m < 4; ++m)
#pragma unroll
                    for (int n = 0; n < 2; ++n) acc[a][b][m][n] = (f32x4){0.f, 0.f, 0.f, 0.f};
        cur = nxt; cA = nA; cB = nB; ++ui;
        if constexpr (GATHER) { _Pragma("unroll") for (int _h = 0; _h < 2; ++_h) _Pragma("unroll") for (int _i = 0; _i < 2; ++_i) vAc[_h][_i] = vAn[_h][_i]; }
        if (wr == 1) PG8_BAR;
    }
    PG8_WAIT_V(0);
    PG8_BAR;
#undef PG8_SA
#undef PG8_SB
#undef PG8_STAGE_A
#undef PG8_STAGE_B
#undef PG8_LDA
#undef PG8_LDB
#undef PG8_MMA
#undef PG8_WAIT_V
#undef PG8_WAIT_L
#undef PG8_BAR
#undef PG8_SCHED
#undef PG8_SETV
}
}

namespace att {
__device__ __forceinline__ int crow(int r, int hi) { return (r & 3) + 8 * (r >> 2) + 4 * hi; }
__device__ __forceinline__ void glds16(const void* gsrc, unsigned lds_dst) { unsigned keep;
    asm volatile("s_mov_b32 %0, m0\n\ts_mov_b32 m0, %2\n\ts_nop 0\n\tglobal_load_lds_dwordx4 %1, off\n\ts_mov_b32 m0, %0" : "=&s"(keep) : "v"(gsrc), "s"(lds_dst) : "memory"); }
typedef short v4i16_t __attribute__((ext_vector_type(4)));
__device__ __forceinline__ s16x4 vtr(const LAS char* p) { return __builtin_bit_cast(s16x4, __builtin_amdgcn_ds_read_tr16_b64_v4i16((LAS v4i16_t*)p)); }
constexpr float THR = 8.0f;
constexpr float NEGB = -1.0e30f;

template <int DQK, int WINDOW, int SINK>
__device__ __forceinline__ void attn_unit(const bf16* Qb, int ldq, const bf16* K1, int ldk1, const bf16* K2, int ldk2, const bf16* Vb, int ldv, bf16* Ob, int ldo,
                                          int qb, float sink_l2, LAS char* shm) {
    constexpr int NKD = DQK / 16, KSLOT = DQK * 128, VSLOT = 8192;
    constexpr int LDS_K = 0, LDS_V = 3 * KSLOT, LDS_WS = LDS_V + 3 * VSLOT, LDS_OST = LDS_WS + 8 * 64 * 4;
    static_assert(LDS_OST + 8 * 4096 <= RING_BYTES, "attention LDS");
    const int tid = threadIdx.x, lane = tid & 63, r32 = lane & 31, hi = lane >> 5; const int wid = __builtin_amdgcn_readfirstlane(tid >> 6);
    const unsigned lds0 = (unsigned)(uintptr_t)shm;
    LAS float* wsf = (LAS float*)(shm + LDS_WS) + wid * 64;
    int NT, lt0 = 0;
    if (qb == 0) NT = 4;
    else if (!WINDOW) NT = 36;
    else { const int q0l = 256 * (qb - 1); const int lo = (q0l >= 128 ? q0l - 128 : 0) >> 6; const int hi_t = ((q0l + 383) < 2047 ? (q0l + 383) : 2047) >> 6; lt0 = lo; NT = 4 + hi_t - lo + 1; }
    const bool dma2 = (DQK == 96) && (wid < 4);
#define KROW(j) (((j) < 4) ? 64 * (j) : 256 + 64 * (lt0 + (j) - 4))
#define ISSUE(j, sl) do { const int kr_ = KROW(j); \
        glds16(K1 + (long)(kr_ + lane) * ldk1 + wid * 8, (unsigned)__builtin_amdgcn_readfirstlane(lds0 + LDS_K + (sl) * KSLOT + wid * 1024)); \
        if (dma2) glds16(K2 + (long)(kr_ + lane) * ldk2 + wid * 8, (unsigned)__builtin_amdgcn_readfirstlane(lds0 + LDS_K + (sl) * KSLOT + (8 + wid) * 1024)); \
        glds16(Vb + (long)(kr_ + 16 * (wid & 3) + (lane >> 2)) * ldv + (wid >> 2) * 32 + (lane & 3) * 8, (unsigned)__builtin_amdgcn_readfirstlane(lds0 + LDS_V + (sl) * VSLOT + wid * 1024)); } while (0)
    ISSUE(0, 0); ISSUE(1, 1);
    const bf16* Qw = Qb + (long)(256 * qb + 32 * wid + r32) * ldq + hi * 8;
    bf16x8 qr[NKD];
#pragma unroll
    for (int d0 = 0; d0 < NKD; ++d0) qr[d0] = *reinterpret_cast<const bf16x8*>(Qw + d0 * 16);
    float m_run = NEGB, l_run = 0.f; f32x16 o[2];
#pragma unroll
    for (int r = 0; r < 16; ++r) { o[0][r] = 0.f; o[1][r] = 0.f; }
    const int qw = 256 * (qb - 1) + 32 * wid;
    int sl = 0;
    for (int j = 0; j < NT; ++j) {
        if (j + 1 < NT) { if (dma2) asm volatile("s_waitcnt vmcnt(3) lgkmcnt(0)\n\ts_barrier" ::: "memory"); else asm volatile("s_waitcnt vmcnt(2) lgkmcnt(0)\n\ts_barrier" ::: "memory"); }
        else asm volatile("s_waitcnt vmcnt(0) lgkmcnt(0)\n\ts_barrier" ::: "memory");
        if (j + 2 < NT) { const int s2 = (sl >= 1) ? sl - 1 : 2; ISSUE(j + 2, s2); }
        const int slc = sl; sl = (sl == 2) ? 0 : sl + 1;
        int mode = 0;
        int k0 = 0;
        if (WINDOW && qb > 0 && j >= 4) { k0 = 64 * (lt0 + j - 4);
            if (k0 + 63 < qw - 128 || k0 > qw + 31 + 128) mode = 2; else if (!(k0 >= qw + 31 - 128 && k0 + 63 <= qw + 128)) mode = 1; }
        if (mode == 2) continue;
        f32x16 p0, p1;
#pragma unroll
        for (int r = 0; r < 16; ++r) { p0[r] = 0.f; p1[r] = 0.f; }
        { const LAS char* kb = shm + LDS_K + slc * KSLOT + hi * 1024 + r32 * 16;
#pragma unroll
          for (int d0 = 0; d0 < NKD; ++d0) { const bf16x8 b0 = *(const LAS bf16x8*)(kb + d0 * 2048); const bf16x8 b1 = *(const LAS bf16x8*)(kb + d0 * 2048 + 512);
              p0 = __builtin_amdgcn_mfma_f32_32x32x16_bf16(b0, qr[d0], p0, 0, 0, 0); p1 = __builtin_amdgcn_mfma_f32_32x32x16_bf16(b1, qr[d0], p1, 0, 0, 0); } }
        if (WINDOW && mode == 1) { const int q = qw + r32;
#pragma unroll
            for (int r = 0; r < 16; ++r) { const int kv = k0 + crow(r, hi); int d0_ = q - kv; d0_ = d0_ < 0 ? -d0_ : d0_; int d1_ = q - kv - 32; d1_ = d1_ < 0 ? -d1_ : d1_;
                if (d0_ > 128) p0[r] = NEGB; if (d1_ > 128) p1[r] = NEGB; } }
        float rm = p0[0];
#pragma unroll
        for (int r = 1; r < 16; ++r) rm = fmaxf(rm, p0[r]);
#pragma unroll
        for (int r = 0; r < 16; ++r) rm = fmaxf(rm, p1[r]);
        { auto rrv = __builtin_amdgcn_permlane32_swap(__float_as_uint(rm), __float_as_uint(rm), false, false); rm = fmaxf(__uint_as_float(rrv[0]), __uint_as_float(rrv[1])); }
        if (__any(rm > m_run + THR)) {
            const float mn = fmaxf(m_run, rm); const float al = fast_exp2(m_run - mn); m_run = mn; l_run *= al;
            if (hi == 0) wsf[r32] = al;
            LDS_WAIT();
#pragma unroll
            for (int r = 0; r < 16; ++r) { const float f = wsf[crow(r, hi)]; o[0][r] *= f; o[1][r] *= f; }
        }
        float ps = 0.f;
#pragma unroll
        for (int r = 0; r < 16; ++r) { p0[r] = fast_exp2(p0[r] - m_run); p1[r] = fast_exp2(p1[r] - m_run); ps += p0[r] + p1[r]; }
        l_run += ps;
        u32x4 pw0, pw1, pw2, pw3;
        pw0 = (u32x4){cvt_pk_bf16(p0[0], p0[1]), cvt_pk_bf16(p0[2], p0[3]), cvt_pk_bf16(p0[4], p0[5]), cvt_pk_bf16(p0[6], p0[7])};
        pw1 = (u32x4){cvt_pk_bf16(p0[8], p0[9]), cvt_pk_bf16(p0[10], p0[11]), cvt_pk_bf16(p0[12], p0[13]), cvt_pk_bf16(p0[14], p0[15])};
        pw2 = (u32x4){cvt_pk_bf16(p1[0], p1[1]), cvt_pk_bf16(p1[2], p1[3]), cvt_pk_bf16(p1[4], p1[5]), cvt_pk_bf16(p1[6], p1[7])};
        pw3 = (u32x4){cvt_pk_bf16(p1[8], p1[9]), cvt_pk_bf16(p1[10], p1[11]), cvt_pk_bf16(p1[12], p1[13]), cvt_pk_bf16(p1[14], p1[15])};
        const bf16x8 pa[4] = {__builtin_bit_cast(bf16x8, pw0), __builtin_bit_cast(bf16x8, pw1), __builtin_bit_cast(bf16x8, pw2), __builtin_bit_cast(bf16x8, pw3)};
        { const LAS char* vp = shm + LDS_V + slc * VSLOT + ((lane >> 4) & 1) * 32 + (lane & 3) * 8 + (4 * hi + ((lane & 15) >> 2)) * 64;
#pragma unroll
          for (int d0 = 0; d0 < 2; ++d0)
#pragma unroll
              for (int ks = 0; ks < 4; ++ks) { const s16x4 lo = vtr(vp + d0 * 4096 + ks * 1024), hh = vtr(vp + d0 * 4096 + ks * 1024 + 512);
                  const bf16x8 vf = (bf16x8){lo[0], lo[1], lo[2], lo[3], hh[0], hh[1], hh[2], hh[3]};
                  o[d0] = __builtin_amdgcn_mfma_f32_32x32x16_bf16(pa[ks], vf, o[d0], 0, 0, 0); } }
    }
    { auto rrv = __builtin_amdgcn_permlane32_swap(__float_as_uint(l_run), __float_as_uint(l_run), false, false); l_run = __uint_as_float(rrv[0]) + __uint_as_float(rrv[1]); }
    if (SINK) l_run += fast_exp2(sink_l2 - m_run);
    if (hi == 0) wsf[32 + r32] = l_run;
    LDS_WAIT();
    float rli[16];
#pragma unroll
    for (int r = 0; r < 16; ++r) rli[r] = fast_rcp(wsf[32 + crow(r, hi)]);
    bf16* Ow = Ob + (long)(256 * qb + 32 * wid) * ldo;
    { LAS bf16* stg = (LAS bf16*)(shm + LDS_OST) + wid * 2048;
#pragma unroll
      for (int r = 0; r < 16; ++r) { const int orow = crow(r, hi);
#pragma unroll
          for (int d0 = 0; d0 < 2; ++d0) { const unsigned w = cvt_pk_bf16(o[d0][r] * rli[r], 0.f); stg[orow * 64 + d0 * 32 + r32] = (bf16)(w & 0xffffu); } }
      LDS_WAIT();
#pragma unroll
      for (int i = 0; i < 4; ++i) { const int row = i * 8 + (lane >> 3), ch = lane & 7; const u32x4 v = *(const LAS u32x4*)(stg + row * 64 + ch * 8); *(u32x4*)(Ow + (long)row * ldo + ch * 8) = v; } }
    asm volatile("s_waitcnt lgkmcnt(0)\n\ts_barrier" ::: "memory");
#undef KROW
#undef ISSUE
}
}

struct WDesc { int in_idx; unsigned src_off; int ldw, K, N; unsigned dst_off; int row_off, mode, F; float scale; int scale_cols; int item0; };
constexpr int N_WDESC = 50;
struct WTab { WDesc d[N_WDESC]; int n; int total; };
constexpr WTab make_wtab() {
    WTab t{}; int n = 0; int items = 0;
    auto add = [&](int in_idx, size_t src_off, int ldw, int K, int N, size_t dst_off, int row_off, int mode, int F, float scale, int scale_cols) {
        t.d[n] = WDesc{in_idx, (unsigned)src_off, ldw, K, N, (unsigned)dst_off, row_off, mode, F, scale, scale_cols, items}; items += (K / 64) * (N / 32); ++n; };
    for (int j = 0; j < 2; ++j) {
        add(I_MLA_DQ, (size_t)j * 1024 * 384, 384, 1024, 384, W_MLA_D(j), 0, 0, 0, 1.f, 0);
        add(I_MLA_DKV, (size_t)j * 1024 * 288, 288, 1024, 288, W_MLA_D(j), 384, 0, 0, 1.f, 0);
        add(I_MLA_UQ, (size_t)j * 384 * 1536, 1536, 384, 1536, W_MLA_UQ(j), 0, 0, 0, QS96, 1536);
        add(I_MLA_UKV, (size_t)j * 256 * 2048, 2048, 256, 2048, W_MLA_UKV(j), 0, 0, 0, 1.f, 0);
        add(I_MLA_O, (size_t)j * 1024 * 1024, 1024, 1024, 1024, W_MLA_O(j), 0, 0, 0, 1.f, 0);
    }
    add(I_SWA_QKV, 0, 1536, 1024, 1536, W_SWA_QKV, 0, 0, 0, QS64, 1024);
    add(I_SWA_O, 0, 1024, 1024, 1024, W_SWA_O, 0, 0, 0, 1.f, 0);
    add(I_GA_QKV, 0, 2048, 1024, 2048, W_GA_QKV, 0, 0, 0, 1.f, 0);
    add(I_GA_O, 0, 1024, 1024, 1024, W_GA_O, 0, 0, 0, 1.f, 0);
    for (int f = 0; f < 2; ++f) {
        add(I_FFN_GU, (size_t)f * 1024 * 2 * FF, 2 * FF, 1024, 2 * FF, W_FFN_GU(f), 0, 1, FF, 1.f, 0);
        add(I_FFN_DN, (size_t)f * FF * 1024, 1024, FF, 1024, W_FFN_DN(f), 0, 0, 0, 1.f, 0);
    }
    for (int f = 0; f < 2; ++f)
        for (int e = 0; e < NEXP; ++e) {
            add(I_MOE_GU, ((size_t)f * NEXP + e) * 1024 * 2 * EFF, 2 * EFF, 1024, 2 * EFF, W_MOE_GU(f) + e * MOE_GU_SZ, 0, 1, EFF, 1.f, 0);
            add(I_MOE_DN, ((size_t)f * NEXP + e) * EFF * 1024, 1024, EFF, 1024, W_MOE_DN(f) + e * MOE_DN_SZ, 0, 0, 0, 1.f, 0);
        }
    t.n = n; t.total = items; return t;
}
__device__ const WTab g_wtab = make_wtab();
static_assert(make_wtab().n == N_WDESC, "descriptor count");

struct Params { const float* in[N_IN]; float* out; unsigned char* ws; int ph_lo, ph_hi; };

__device__ __forceinline__ void tr_item(const float* W, const WDesc& d, bf16* WT, LAS float* scr, int item, int lane) {
    const int nblk = d.N / 32, kb = item / nblk, nb = item - kb * nblk, k0 = 64 * kb, n0 = 32 * nb;
    const float sc = (n0 < d.scale_cols) ? d.scale : 1.0f;
#pragma unroll 8
    for (int i = 0; i < 32; ++i) { const int kk = 2 * i + (lane >> 5); scr[kk * 33 + (lane & 31)] = W[(size_t)(k0 + kk) * d.ldw + n0 + (lane & 31)] * sc; }
    LDS_WAIT(); asm volatile("" ::: "memory");
    const int c = lane & 7;
#pragma unroll
    for (int j = 0; j < 4; ++j) { const int n = (lane >> 3) + 8 * j; const LAS float* s = scr + (8 * c) * 33 + n;
        const int ng = n0 + n; int row;
        if (d.mode == 0) row = d.row_off + ng;
        else { const int up = ng >= d.F ? 1 : 0; const int jj = ng - up * d.F; row = (jj >> 7) * 256 + up * 128 + (jj & 127); }
        u32x4 o; o.x = cvt_pk_bf16(s[0 * 33], s[1 * 33]); o.y = cvt_pk_bf16(s[2 * 33], s[3 * 33]); o.z = cvt_pk_bf16(s[4 * 33], s[5 * 33]); o.w = cvt_pk_bf16(s[6 * 33], s[7 * 33]);
        *(GAS u32x4*)(WT + (size_t)row * d.K + k0 + 8 * c) = o; }
    LDS_WAIT(); asm volatile("" ::: "memory");
}

__device__ __forceinline__ void p0_prologue(const Params& P, LAS unsigned char* lds, int tid, int lane, int wave, int G) {
    unsigned char* ws = P.ws;
    float* MOD = (float*)(ws + WS_MOD);
    LAS float* sS = (LAS float*)(lds + RING_OFF); LAS float* red = (LAS float*)(lds + RING_OFF + 36864);
    for (int i = tid; i < 9 * 1024; i += 512) { const float v = (i < 8192) ? P.in[I_C][i] : P.in[I_CCTX][i - 8192]; sS[i] = v * fast_rcp(1.0f + fast_exp2(-v * LOG2E)); }
    __syncthreads();
    for (int it = blockIdx.x; it < 4 * 96; it += G) {
        const int l = it / 96, cc = it - l * 96; const float* wp = P.in[I_ADAW] + ((size_t)l * 1024 + 128 * wave) * 6144 + cc * 64 + lane;
        float a[9];
#pragma unroll
        for (int r = 0; r < 9; ++r) a[r] = 0.f;
#pragma unroll 8
        for (int k = 0; k < 128; ++k) { const float wv = wp[(size_t)k * 6144];
#pragma unroll
            for (int r = 0; r < 9; ++r) a[r] += sS[r * 1024 + 128 * wave + k] * wv; }
#pragma unroll
        for (int r = 0; r < 9; ++r) red[(wave * 9 + r) * 64 + lane] = a[r];
        __syncthreads();
        for (int o = tid; o < 9 * 64; o += 512) { const int r = o >> 6, cl = o & 63; float s = P.in[I_ADAB][l * 6144 + cc * 64 + cl];
#pragma unroll
            for (int w = 0; w < 8; ++w) s += red[(w * 9 + r) * 64 + cl];
            MOD[((size_t)l * 9 + r) * 6144 + cc * 64 + cl] = s; }
        __syncthreads();
    }
    bf16* Wb = (bf16*)(ws + WS_W);
    LAS float* scr = (LAS float*)(lds + RING_OFF + wave * 16384);
    const int gw = blockIdx.x * 8 + wave, NGW = G * 8;
    const int total = g_wtab.total;
    int di = 0;
    for (int it = gw; it < total; it += NGW) {
        while (di + 1 < N_WDESC && g_wtab.d[di + 1].item0 <= it) ++di;
        const WDesc d = g_wtab.d[di];
        tr_item(P.in[d.in_idx] + d.src_off, d, Wb + d.dst_off, scr, it - d.item0, lane);
    }
    for (int i = gw * 64 + lane; i < 2 * 96 * 128; i += NGW * 64) { const int j = i / (96 * 128), r = i - j * 96 * 128; *(GAS u32x4*)(Wb + W_MLA_D(j) + (size_t)672 * 1024 + (size_t)r * 8) = (u32x4){0u, 0u, 0u, 0u}; }
}

struct RowVec { f32x4 v[4]; };
__device__ __forceinline__ void ld_row_f32(RowVec& r, const float* p, int lane) {
#pragma unroll
    for (int j = 0; j < 4; ++j) r.v[j] = *(const f32x4*)(p + 4 * lane + 256 * j);
}
__device__ __forceinline__ void moe_setup(volatile LAS unsigned* misc, gu32* cntw, int tid) {
    if (tid == 0) {
        unsigned p = 0;
        for (int e = 0; e < NEXP; ++e) { const unsigned c = __hip_atomic_load(cntw + 64 * e, RLX_AGENT); const unsigned np = (c + 255u) >> 8;
            misc[MW_CNT + e] = c; misc[MW_OFF + e] = p * 256u;
            for (unsigned lp = 0; lp < np; ++lp) misc[MW_TAB + p + lp] = ((unsigned)e << 16) | lp;
            p += np; }
        misc[MW_NP] = p;
    }
    __syncthreads();
}

template <bool SRC_IN, bool COMBINE, bool OUT_H, bool ROUTER, bool FINAL>
__device__ __forceinline__ void row_phase(const Params& P, LAS unsigned char* lds, volatile LAS unsigned* misc, int tid, int lane, int wave, int G, bool latent_only,
                                          const float* gn, const float* modA, int shift_idx, const float* modG, int moe_f_comb, int moe_f_route) {
    unsigned char* ws = P.ws;
    float* X = (float*)(ws + WS_X); bf16* H = (bf16*)(ws + WS_H); const bf16* YS = (const bf16*)(ws + WS_S + S_YS);
    int* INFO = (int*)(ws + WS_INFO);
    gu32* ctl = (gu32*)(ws + WS_CTL);
    LAS float* rwT = (LAS float*)(lds + RING_OFF);
    if (COMBINE) moe_setup(misc, ctl + CW_CNT + moe_f_comb * 1024, tid);
    if (ROUTER) { const float* rw = P.in[I_MOE_RW] + (size_t)moe_f_route * 1024 * 8;
        for (int i = tid; i < 8192; i += 512) rwT[(i & 7) * 1024 + (i >> 3)] = rw[i];
        __syncthreads(); }
    RowVec g; ld_row_f32(g, gn, lane);
    RowVec sh, scl, gt; int cur_mi = -1;
    const int gw = blockIdx.x * 8 + wave, NGW = G * 8;
    for (int ch = gw; ch < T / 9; ch += NGW) {
        for (int rI = 0; rI < 9; ++rI) {
            const int row = ch * 9 + rI; const int b = row / RPB, rr = row - b * RPB; const bool isctx = rr < CTXL;
            if (latent_only && isctx) continue;
            const int mi = isctx ? 8 : b;
            if (mi != cur_mi) { cur_mi = mi;
                if (OUT_H) { ld_row_f32(sh, modA + ((size_t)mi * 6 + shift_idx) * 1024, lane); ld_row_f32(scl, modA + ((size_t)mi * 6 + shift_idx + 1) * 1024, lane); }
                if (COMBINE) ld_row_f32(gt, modG + ((size_t)mi * 6 + 5) * 1024, lane); }
            RowVec x;
            if (SRC_IN) { const float* src = isctx ? P.in[I_CTX] + ((size_t)b * CTXL + rr) * DM : P.in[I_X] + ((size_t)b * SEQ + (rr - CTXL)) * DM; ld_row_f32(x, src, lane); }
            else ld_row_f32(x, X + (size_t)row * DM, lane);
            if (COMBINE) {
                const i32x4 ia = *(const i32x4*)(INFO + (size_t)row * 8), ib = *(const i32x4*)(INFO + (size_t)row * 8 + 4);
                const int sa = (int)misc[MW_OFF + ia.x] + ia.y, sb = (int)misc[MW_OFF + ib.x] + ib.y; const float wa = __int_as_float(ia.z), wb = __int_as_float(ib.z);
                const bf16* ya = YS + (size_t)sa * DM + 4 * lane; const bf16* yb = YS + (size_t)sb * DM + 4 * lane;
#pragma unroll
                for (int j = 0; j < 4; ++j) { const u32x2 a = *(const u32x2*)(ya + 256 * j), c = *(const u32x2*)(yb + 256 * j);
                    f32x4 y; y.x = wa * bf_lo(a.x) + wb * bf_lo(c.x); y.y = wa * bf_hi(a.x) + wb * bf_hi(c.x); y.z = wa * bf_lo(a.y) + wb * bf_lo(c.y); y.w = wa * bf_hi(a.y) + wb * bf_hi(c.y);
                    x.v[j] = x.v[j] + gt.v[j] * y; }
            }
            if (SRC_IN || COMBINE) {
#pragma unroll
                for (int j = 0; j < 4; ++j) *(f32x4*)(X + (size_t)row * DM + 4 * lane + 256 * j) = x.v[j]; }
            float ss = 0.f;
#pragma unroll
            for (int j = 0; j < 4; ++j) ss += (x.v[j].x * x.v[j].x + x.v[j].y * x.v[j].y) + (x.v[j].z * x.v[j].z + x.v[j].w * x.v[j].w);
            const float rstd = 1.0f / sqrtf(wave_sum(ss) * (1.0f / DM) + NORM_EPS);
            if (FINAL) { if (!isctx) { float* op = P.out + ((size_t)b * SEQ + (rr - CTXL)) * DM + 4 * lane;
#pragma unroll
                    for (int j = 0; j < 4; ++j) *(f32x4*)(op + 256 * j) = x.v[j] * rstd * g.v[j]; } }
            if (OUT_H) {
                RowVec h;
#pragma unroll
                for (int j = 0; j < 4; ++j) { h.v[j] = (x.v[j] * rstd * g.v[j]) * (1.0f + scl.v[j]) + sh.v[j];
                    u32x2 w; w.x = cvt_pk_bf16(h.v[j].x, h.v[j].y); w.y = cvt_pk_bf16(h.v[j].z, h.v[j].w); *(u32x2*)(H + (size_t)row * DM + 4 * lane + 256 * j) = w; }
                if (ROUTER) {
                    float lg[NEXP];
#pragma unroll
                    for (int e = 0; e < NEXP; ++e) { float s = 0.f;
#pragma unroll
                        for (int j = 0; j < 4; ++j) { const f32x4 w = *(const LAS f32x4*)(rwT + e * 1024 + 4 * lane + 256 * j); s += (h.v[j].x * w.x + h.v[j].y * w.y) + (h.v[j].z * w.z + h.v[j].w * w.w); }
                        lg[e] = wave_sum(s) + P.in[I_MOE_RB][moe_f_route * NEXP + e]; }
                    int i1 = 0; float v1 = lg[0];
#pragma unroll
                    for (int e = 1; e < NEXP; ++e) if (lg[e] > v1) { v1 = lg[e]; i1 = e; }
                    int i2 = -1; float v2 = -3.0e38f;
#pragma unroll
                    for (int e = 0; e < NEXP; ++e) if (e != i1 && lg[e] > v2) { v2 = lg[e]; i2 = e; }
                    const float ex = fast_exp2((v2 - v1) * LOG2E); const float w1 = 1.0f / (1.0f + ex), w2 = ex * w1;
                    if (lane == 0) {
                        gu32* cw = ctl + CW_CNT + moe_f_route * 1024; int* LIST = (int*)(ws + WS_LIST) + (size_t)moe_f_route * NEXP * T;
                        const unsigned p1 = __hip_atomic_fetch_add(cw + 64 * i1, 1u, RLX_AGENT), p2 = __hip_atomic_fetch_add(cw + 64 * i2, 1u, RLX_AGENT);
                        LIST[(size_t)i1 * T + p1] = row; LIST[(size_t)i2 * T + p2] = row;
                        *(i32x4*)(INFO + (size_t)row * 8) = (i32x4){i1, (int)p1, __float_as_int(w1), 0}; *(i32x4*)(INFO + (size_t)row * 8 + 4) = (i32x4){i2, (int)p2, __float_as_int(w2), 0};
                    }
                }
            }
        }
    }
}

__device__ __forceinline__ void mla_mid_phase(const Params& P, int lane, int wave, int G, int jm) {
    unsigned char* ws = P.ws;
    const bf16* DOWN = (const bf16*)(ws + WS_S + S_DOWN); bf16* QN = (bf16*)(ws + WS_S + S_QN); bf16* CKV = (bf16*)(ws + WS_S + S_CKV); bf16* KR = (bf16*)(ws + WS_S + S_KR);
    const float* gq = P.in[I_MLA_QNG] + jm * 384; const float* gk = P.in[I_MLA_KVNG] + jm * 256;
    float gqv[6]; f32x4 gkv;
#pragma unroll
    for (int j = 0; j < 3; ++j) { gqv[2 * j] = gq[2 * lane + 128 * j]; gqv[2 * j + 1] = gq[2 * lane + 128 * j + 1]; }
    gkv = *(const f32x4*)(gk + 4 * lane);
    const int gw = blockIdx.x * 8 + wave, NGW = G * 8;
    for (int row = gw; row < T; row += NGW) {
        const int b = row / RPB, rr = row - b * RPB; const bool isctx = rr < CTXL;
        const bf16* dr = DOWN + (size_t)row * 768;
        float q[6]; float ss = 0.f;
#pragma unroll
        for (int j = 0; j < 3; ++j) { const unsigned u = *(const unsigned*)(dr + 2 * lane + 128 * j); q[2 * j] = bf_lo(u); q[2 * j + 1] = bf_hi(u); ss += q[2 * j] * q[2 * j] + q[2 * j + 1] * q[2 * j + 1]; }
        const float rq = 1.0f / sqrtf(wave_sum(ss) * (1.0f / 384.0f) + NORM_EPS);
#pragma unroll
        for (int j = 0; j < 3; ++j) *(unsigned*)(QN + (size_t)row * 384 + 2 * lane + 128 * j) = cvt_pk_bf16(q[2 * j] * rq * gqv[2 * j], q[2 * j + 1] * rq * gqv[2 * j + 1]);
        const u32x2 cu = *(const u32x2*)(dr + 384 + 4 * lane);
        const float c0 = bf_lo(cu.x), c1 = bf_hi(cu.x), c2 = bf_lo(cu.y), c3 = bf_hi(cu.y);
        const float rc = 1.0f / sqrtf(wave_sum((c0 * c0 + c1 * c1) + (c2 * c2 + c3 * c3)) * (1.0f / 256.0f) + NORM_EPS);
        { u32x2 w; w.x = cvt_pk_bf16(c0 * rc * gkv.x, c1 * rc * gkv.y); w.y = cvt_pk_bf16(c2 * rc * gkv.z, c3 * rc * gkv.w); *(u32x2*)(CKV + (size_t)row * 256 + 4 * lane) = w; }
        if (lane < 16) {
            const float x1 = bf_lo((unsigned)dr[640 + lane]), x2 = bf_lo((unsigned)dr[656 + lane]);
            float o1 = x1, o2 = x2;
            if (!isctx) { const int pos = rr - CTXL; const float pr = (float)(pos >> 6), pc = (float)(pos & 63);
                const float inv = fast_exp2(-(float)(lane & 7) * (13.287712379549449f / 8.0f)); float sn, cs; sincos_rad(((lane < 8) ? pr : pc) * inv, sn, cs);
                o1 = x1 * cs - x2 * sn; o2 = x2 * cs + x1 * sn; }
            KR[(size_t)row * 32 + lane] = (bf16)(cvt_pk_bf16(o1, 0.f) & 0xffffu); KR[(size_t)row * 32 + 16 + lane] = (bf16)(cvt_pk_bf16(o2, 0.f) & 0xffffu);
        }
    }
}

__device__ __forceinline__ void mla_qpost_phase(const Params& P, int lane, int wave, int G) {
    bf16* QM = (bf16*)(P.ws + WS_S + S_QM);
    const int gw = blockIdx.x * 8 + wave, NGW = G * 8; const int hq = lane >> 2, d4 = 4 * (lane & 3);
    float inv[4];
#pragma unroll
    for (int e = 0; e < 4; ++e) inv[e] = fast_exp2(-(float)((d4 + e) & 7) * (13.287712379549449f / 8.0f));
    for (int row = gw; row < T; row += NGW) {
        const int b = row / RPB, rr = row - b * RPB; if (rr < CTXL) continue;
        const int pos = rr - CTXL; const float pr = (float)(pos >> 6), pc = (float)(pos & 63);
        bf16* p1 = QM + (size_t)row * 1536 + hq * 96 + 64 + d4; bf16* p2 = p1 + 16;
        const u32x2 a = *(const u32x2*)p1, c = *(const u32x2*)p2;
        const float x1[4] = {bf_lo(a.x), bf_hi(a.x), bf_lo(a.y), bf_hi(a.y)}, x2[4] = {bf_lo(c.x), bf_hi(c.x), bf_lo(c.y), bf_hi(c.y)};
        float o1[4], o2[4];
#pragma unroll
        for (int e = 0; e < 4; ++e) { float sn, cs; sincos_rad((((d4 + e) < 8) ? pr : pc) * inv[e], sn, cs); o1[e] = x1[e] * cs - x2[e] * sn; o2[e] = x2[e] * cs + x1[e] * sn; }
        u32x2 w1, w2; w1.x = cvt_pk_bf16(o1[0], o1[1]); w1.y = cvt_pk_bf16(o1[2], o1[3]); w2.x = cvt_pk_bf16(o2[0], o2[1]); w2.y = cvt_pk_bf16(o2[2], o2[3]);
        *(u32x2*)p1 = w1; *(u32x2*)p2 = w2;
    }
}

template <bool NORM>
__device__ __forceinline__ void qk_post_phase(const Params& P, int lane, int wave, int G, int ld, int nkv, const float* gqp, const float* gkp, float qscale) {
    bf16* QKV = (bf16*)(P.ws + WS_S + S_QKV);
    const int gw = blockIdx.x * 8 + wave, NGW = G * 8; const int hs = lane >> 3, d4 = 4 * (lane & 7); const int nh = 16 + nkv;
    float inv[4];
#pragma unroll
    for (int e = 0; e < 4; ++e) inv[e] = fast_exp2(-(float)((d4 + e) & 15) * (13.287712379549449f / 16.0f));
    f32x4 gq1 = {1.f, 1.f, 1.f, 1.f}, gq2 = gq1, gk1 = gq1, gk2 = gq1;
    if (NORM) { gq1 = *(const f32x4*)(gqp + d4) * qscale; gq2 = *(const f32x4*)(gqp + 32 + d4) * qscale; gk1 = *(const f32x4*)(gkp + d4); gk2 = *(const f32x4*)(gkp + 32 + d4); }
    for (int row = gw; row < T; row += NGW) {
        const int b = row / RPB, rr = row - b * RPB; const bool isctx = rr < CTXL;
        if (!NORM && isctx) continue;
        const int pos = rr - CTXL; const float pr = (float)(pos >> 6), pc = (float)(pos & 63);
        float sn[4], cs[4];
#pragma unroll
        for (int e = 0; e < 4; ++e) { if (isctx) { sn[e] = 0.f; cs[e] = 1.f; } else sincos_rad((((d4 + e) < 16) ? pr : pc) * inv[e], sn[e], cs[e]); }
        for (int h0 = 0; h0 < nh; h0 += 8) {
            const int hd = h0 + hs; const bool act = hd < nh; const int hh = act ? hd : 0;
            bf16* p1 = QKV + (size_t)row * ld + hh * 64 + d4; bf16* p2 = p1 + 32;
            const u32x2 a = *(const u32x2*)p1, c = *(const u32x2*)p2;
            float x1[4] = {bf_lo(a.x), bf_hi(a.x), bf_lo(a.y), bf_hi(a.y)}, x2[4] = {bf_lo(c.x), bf_hi(c.x), bf_lo(c.y), bf_hi(c.y)};
            if (NORM) { float ss = 0.f;
#pragma unroll
                for (int e = 0; e < 4; ++e) ss += x1[e] * x1[e] + x2[e] * x2[e];
                ss += __shfl_xor(ss, 1); ss += __shfl_xor(ss, 2); ss += __shfl_xor(ss, 4);
                const float rs = 1.0f / sqrtf(ss * (1.0f / 64.0f) + NORM_EPS); const bool isq = hd < 16;
#pragma unroll
                for (int e = 0; e < 4; ++e) { x1[e] *= rs * (isq ? gq1[e] : gk1[e]); x2[e] *= rs * (isq ? gq2[e] : gk2[e]); } }
            float o1[4], o2[4];
#pragma unroll
            for (int e = 0; e < 4; ++e) { o1[e] = x1[e] * cs[e] - x2[e] * sn[e]; o2[e] = x2[e] * cs[e] + x1[e] * sn[e]; }
            if (act) { u32x2 w1, w2; w1.x = cvt_pk_bf16(o1[0], o1[1]); w1.y = cvt_pk_bf16(o1[2], o1[3]); w2.x = cvt_pk_bf16(o2[0], o2[1]); w2.y = cvt_pk_bf16(o2[2], o2[3]);
                *(u32x2*)p1 = w1; *(u32x2*)p2 = w2; }
        }
    }
}

#define XB_TMO      128
#define XB_XCNT(j)  (256  + 64 * (j))
#define XB_XSUB(j)  (1280 + 64 * (j))
#define XB_XGEN(j)  (2304 + 64 * (j))
#define XB_TOP      3328
#define XB_TOPGEN   3392
#define XCD_BAR_WORDS 3456
#define XB_SPIN_CAP (1u << 18)
__device__ __forceinline__ unsigned xb_ld(unsigned* p)              { return __hip_atomic_load(p, __ATOMIC_RELAXED, __HIP_MEMORY_SCOPE_AGENT); }
__device__ __forceinline__ unsigned xb_add(unsigned* p, unsigned v) { return __hip_atomic_fetch_add(p, v, __ATOMIC_RELAXED, __HIP_MEMORY_SCOPE_AGENT); }
__device__ __forceinline__ unsigned xb_xcc_id() { return (unsigned)__builtin_amdgcn_s_getreg((3 << 11) | 20) & 0xFu; }
#define XB_SPIN(cond, bar) do { unsigned _sp = 0; while (cond) { __builtin_amdgcn_s_sleep(1); \
    if ((++_sp & 255u) == 0u) { if (xb_ld(&(bar)[XB_TMO])) break; if (_sp > XB_SPIN_CAP) { atomicAdd(&(bar)[XB_TMO], 1u); break; } } } } while (0)
struct XcdBarrier { unsigned* bar; unsigned x; volatile LAS unsigned* st; };
__device__ __forceinline__ XcdBarrier xcd_barrier_post(unsigned* bar, volatile LAS unsigned* st) {
    XcdBarrier b; b.bar = bar; b.x = xb_xcc_id(); b.st = st;
    if (threadIdx.x == 0) (void)xb_add(&bar[XB_XCNT(b.x)], 1u);
    return b;
}
__device__ __forceinline__ void xcd_barrier_complete(unsigned* bar, unsigned x, unsigned& nloc, unsigned& nx) {
    const unsigned G = gridDim.x * gridDim.y * gridDim.z;
    unsigned sum, cnt, mine, sp = 0u;
    for (;;) {
        sum = 0u; cnt = 0u; mine = 0u;
#pragma unroll
        for (unsigned j = 0; j < 16; ++j) { const unsigned c = xb_ld(&bar[XB_XCNT(j)]); sum += c; cnt += (c > 0u) ? 1u : 0u; mine = (j == x) ? c : mine; }
        if (sum == G) break;
        __builtin_amdgcn_s_sleep(1);
        if ((++sp & 255u) == 0u) { if (xb_ld(&bar[XB_TMO])) break; if (sp > XB_SPIN_CAP) { atomicAdd(&bar[XB_TMO], 1u); break; } }
    }
    nloc = mine > 0u ? mine : 1u; nx = cnt > 0u ? cnt : 1u;
}
__device__ __forceinline__ void xcd_barrier(const XcdBarrier& b) {
    asm volatile("s_waitcnt vmcnt(0)" ::: "memory");
    __syncthreads();
    if (threadIdx.x == 0) {
        unsigned* bar = b.bar;
        __builtin_amdgcn_s_waitcnt(0);
        unsigned nloc = b.st[0], nx = b.st[1];
        if (nloc == 0u) { xcd_barrier_complete(bar, b.x, nloc, nx); b.st[0] = nloc; b.st[1] = nx; }
        const unsigned old = xb_add(&bar[XB_XSUB(b.x)], 1u);
        const unsigned gen = old / nloc;
        if (old + 1u == (gen + 1u) * nloc) {
            __builtin_amdgcn_fence(__ATOMIC_RELEASE, "agent");
            asm volatile("s_waitcnt vmcnt(0)" ::: "memory");
            const unsigned og = xb_add(&bar[XB_TOP], 1u);
            const unsigned tg = og / nx;
            if (og + 1u == (tg + 1u) * nx) xb_add(&bar[XB_TOPGEN], 1u);
            else XB_SPIN(xb_ld(&bar[XB_TOPGEN]) == tg, bar);
            __builtin_amdgcn_fence(__ATOMIC_ACQUIRE, "agent");
            xb_add(&bar[XB_XGEN(b.x)], 1u);
            asm volatile("s_waitcnt vmcnt(0)" ::: "memory");
        } else {
            XB_SPIN(xb_ld(&bar[XB_XGEN(b.x)]) == gen, bar);
            __builtin_amdgcn_fence(__ATOMIC_ACQUIRE, "agent");
            asm volatile("s_waitcnt vmcnt(0)" ::: "memory");
        }
    }
    __syncthreads();
}

template <int KIND>
__device__ __forceinline__ void attn_phase(const Params& P, LAS unsigned char* lds, int vcu, int G, bool need_ctx) {
    unsigned char* ws = P.ws; bf16* O = (bf16*)(ws + WS_O);
    const int nun = 1024 + (need_ctx ? 128 : 0);
    for (int idx = vcu; idx < nun; idx += G) {
        int bh, qb; if (idx < 1024) { bh = idx >> 3; qb = 1 + (idx & 7); } else { bh = idx - 1024; qb = 0; }
        const int b = bh >> 4, hq = bh & 15; const long r0 = (long)b * RPB;
        if (KIND == 0) { const bf16* QM = (const bf16*)(ws + WS_S + S_QM); const bf16* KVM = (const bf16*)(ws + WS_S + S_KVM); const bf16* KR = (const bf16*)(ws + WS_S + S_KR);
            att::attn_unit<96, 0, 0>(QM + r0 * 1536 + hq * 96, 1536, KVM + r0 * 2048 + hq * 128, 2048, KR + r0 * 32, 32, KVM + r0 * 2048 + hq * 128 + 64, 2048, O + r0 * 1024 + hq * 64, 1024, qb, 0.f, (LAS char*)(lds + RING_OFF)); }
        else if (KIND == 1) { const bf16* QKV = (const bf16*)(ws + WS_S + S_QKV); const int hk = hq >> 2; const float sk = P.in[I_SWA_SINK][hq] * LOG2E;
            att::attn_unit<64, 1, 1>(QKV + r0 * 1536 + hq * 64, 1536, QKV + r0 * 1536 + 1024 + hk * 64, 1536, nullptr, 0, QKV + r0 * 1536 + 1280 + hk * 64, 1536, O + r0 * 1024 + hq * 64, 1024, qb, sk, (LAS char*)(lds + RING_OFF)); }
        else { const bf16* QKV = (const bf16*)(ws + WS_S + S_QKV); const int hk = hq >> 1;
            att::attn_unit<64, 0, 0>(QKV + r0 * 2048 + hq * 64, 2048, QKV + r0 * 2048 + 1024 + hk * 64, 2048, nullptr, 0, QKV + r0 * 2048 + 1536 + hk * 64, 2048, O + r0 * 1024 + hq * 64, 1024, qb, 0.f, (LAS char*)(lds + RING_OFF)); }
    }
}

constexpr int N_PHASES = 38;
__global__ void __launch_bounds__(512, 2) mk_fwd(Params P) {
    extern __shared__ __attribute__((aligned(16))) unsigned char lds_raw[];
    LAS unsigned char* lds = (LAS unsigned char*)lds_raw;
    volatile LAS unsigned* MISC = (volatile LAS unsigned*)(lds + MISC_OFF);
    const int tid = threadIdx.x, lane = tid & 63, wave = __builtin_amdgcn_readfirstlane(tid >> 6);
    const int G = gridDim.x; const int bx = blockIdx.x; const int vcu = (G % 8 == 0) ? (bx % 8) * (G / 8) + bx / 8 : bx;
    unsigned char* ws = P.ws;
    gu32* ctl = (gu32*)(ws + WS_CTL);
    for (int u = tid; u < (LDS_BYTES - MISC_OFF) / 4; u += 512) ((LAS unsigned*)(lds + MISC_OFF))[u] = 0u;
    __syncthreads();
    XcdBarrier bar; bar.bar = (unsigned*)(ctl + CW_BAR); bar.x = 0; bar.st = nullptr;
    if (!MK_SPLIT) bar = xcd_barrier_post((unsigned*)(ctl + CW_BAR), MISC + 8);
    const int lo = P.ph_lo, hi = P.ph_hi;
#define IN(k) (lo <= (k) && (k) < hi)
#define SEAM(k) do { if (IN((k) + 1)) { if (MK_SPLIT) { if (tid == 0) __hip_atomic_store(ctl + CW_TMO, 0xBADBA0u, RLX_AGENT); } else xcd_barrier(bar); } } while (0)
    float* X = (float*)(ws + WS_X); bf16* H = (bf16*)(ws + WS_H); bf16* O = (bf16*)(ws + WS_O); bf16* Wb = (bf16*)(ws + WS_W);
    const float* MOD = (const float*)(ws + WS_MOD);
    bf16* SB = (bf16*)(ws + WS_S);
    bf16* QKV = (bf16*)(ws + WS_S + S_QKV); bf16* DOWN = (bf16*)(ws + WS_S + S_DOWN); bf16* QN = (bf16*)(ws + WS_S + S_QN); bf16* CKV = (bf16*)(ws + WS_S + S_CKV);
    bf16* QM = (bf16*)(ws + WS_S + S_QM); bf16* KVM = (bf16*)(ws + WS_S + S_KVM); bf16* HH = (bf16*)(ws + WS_S + S_HH); bf16* HS = (bf16*)(ws + WS_S + S_HS); bf16* YS = (bf16*)(ws + WS_S + S_YS);
    (void)SB; (void)O;
    const float* NG = P.in[I_NORMG];
    LAS unsigned char* ring = lds + RING_OFF;

#define GEMM_BF16(Aptr, Wptr, Nn, Kk, Optr, ldc_, latonly) do { pg8::Gemm g_{Aptr, Wptr, Nn, Kk}; pg8::DenseOrder S_; S_.init((latonly) ? 64 : NPAN, (Nn) / 256, G, bx, (latonly) ? 1 : 0); \
        pg8::EpiBf16 E_{Optr, ldc_}; pg8::gemm_phase<pg8::EpiBf16, pg8::DenseOrder, false>(ring, g_, S_, E_); } while (0)
#define GEMM_RESID(Aptr, Wptr, Kk, layer, gidx, latonly) do { pg8::Gemm g_{Aptr, Wptr, 1024, Kk}; pg8::DenseOrder S_; S_.init((latonly) ? 64 : NPAN, 4, G, bx, (latonly) ? 1 : 0); \
        pg8::EpiResid E_{X, MOD + (size_t)(layer) * 9 * 6144 + (gidx) * 1024}; pg8::gemm_phase<pg8::EpiResid, pg8::DenseOrder, false>(ring, g_, S_, E_); } while (0)
#define GEMM_SWIGLU(Wptr) do { pg8::Gemm g_{H, Wptr, 2 * FF, 1024}; pg8::DenseOrder S_; S_.init(NPAN, 2 * FF / 256, G, bx, 0); \
        pg8::EpiSwiglu E_{HH, FF}; pg8::gemm_phase<pg8::EpiSwiglu, pg8::DenseOrder, false>(ring, g_, S_, E_); } while (0)
#define MOE_GU(f) do { moe_setup(MISC, ctl + CW_CNT + (f) * 1024, tid); pg8::Gemm g_{H, Wb + W_MOE_GU(f), 2 * EFF, 1024}; \
        pg8::MoeOrder S_{MISC, (const int*)(ws + WS_LIST) + (size_t)(f) * NEXP * T, 2 * EFF / 256, G, bx, 1}; \
        pg8::EpiSwiglu E_{HS, EFF}; pg8::gemm_phase<pg8::EpiSwiglu, pg8::MoeOrder, true>(ring, g_, S_, E_); } while (0)
#define MOE_DN(f) do { moe_setup(MISC, ctl + CW_CNT + (f) * 1024, tid); pg8::Gemm g_{HS, Wb + W_MOE_DN(f), 1024, EFF}; \
        pg8::MoeOrder S_{MISC, (const int*)(ws + WS_LIST) + (size_t)(f) * NEXP * T, 4, G, bx, 0}; \
        pg8::EpiBf16 E_{YS, 1024}; pg8::gemm_phase<pg8::EpiBf16, pg8::MoeOrder, false>(ring, g_, S_, E_); } while (0)

    if (IN(0)) { p0_prologue(P, lds, tid, lane, wave, G); SEAM(0); }
    if (IN(1)) { row_phase<true, false, true, false, false>(P, lds, MISC, tid, lane, wave, G, false, NG + 0 * 2048 + 0, MOD + 0 * 9 * 6144, 0, nullptr, 0, 0); SEAM(1); }
    if (IN(2)) { GEMM_BF16(H, Wb + W_MLA_D(0), 768, 1024, DOWN, 768, false); SEAM(2); }
    if (IN(3)) { mla_mid_phase(P, lane, wave, G, 0); SEAM(3); }
    if (IN(4)) { GEMM_BF16(QN, Wb + W_MLA_UQ(0), 1536, 384, QM, 1536, false); GEMM_BF16(CKV, Wb + W_MLA_UKV(0), 2048, 256, KVM, 2048, false); SEAM(4); }
    if (IN(5)) { mla_qpost_phase(P, lane, wave, G); SEAM(5); }
    if (IN(6)) { attn_phase<0>(P, lds, vcu, G, true); SEAM(6); }
    if (IN(7)) { GEMM_RESID(O, Wb + W_MLA_O(0), 1024, 0, 2, false); SEAM(7); }
    if (IN(8)) { row_phase<false, false, true, false, false>(P, lds, MISC, tid, lane, wave, G, false, NG + 0 * 2048 + 1024, MOD + 0 * 9 * 6144, 3, nullptr, 0, 0); SEAM(8); }
    if (IN(9)) { GEMM_SWIGLU(Wb + W_FFN_GU(0)); SEAM(9); }
    if (IN(10)) { GEMM_RESID(HH, Wb + W_FFN_DN(0), FF, 0, 5, false); SEAM(10); }
    if (IN(11)) { row_phase<false, false, true, false, false>(P, lds, MISC, tid, lane, wave, G, false, NG + 1 * 2048 + 0, MOD + 1 * 9 * 6144, 0, nullptr, 0, 0); SEAM(11); }
    if (IN(12)) { GEMM_BF16(H, Wb + W_SWA_QKV, 1536, 1024, QKV, 1536, false); SEAM(12); }
    if (IN(13)) { qk_post_phase<false>(P, lane, wave, G, 1536, 4, nullptr, nullptr, 1.0f); SEAM(13); }
    if (IN(14)) { attn_phase<1>(P, lds, vcu, G, true); SEAM(14); }
    if (IN(15)) { GEMM_RESID(O, Wb + W_SWA_O, 1024, 1, 2, false); SEAM(15); }
    if (IN(16)) { row_phase<false, false, true, true, false>(P, lds, MISC, tid, lane, wave, G, false, NG + 1 * 2048 + 1024, MOD + 1 * 9 * 6144, 3, nullptr, 0, 0); SEAM(16); }
    if (IN(17)) { MOE_GU(0); SEAM(17); }
    if (IN(18)) { MOE_DN(0); SEAM(18); }
    if (IN(19)) { row_phase<false, true, true, false, false>(P, lds, MISC, tid, lane, wave, G, false, NG + 2 * 2048 + 0, MOD + 2 * 9 * 6144, 0, MOD + 1 * 9 * 6144, 0, 0); SEAM(19); }
    if (IN(20)) { GEMM_BF16(H, Wb + W_GA_QKV, 2048, 1024, QKV, 2048, false); SEAM(20); }
    if (IN(21)) { qk_post_phase<true>(P, lane, wave, G, 2048, 8, P.in[I_GA_QNG], P.in[I_GA_KNG], QS64); SEAM(21); }
    if (IN(22)) { attn_phase<2>(P, lds, vcu, G, true); SEAM(22); }
    if (IN(23)) { GEMM_RESID(O, Wb + W_GA_O, 1024, 2, 2, false); SEAM(23); }
    if (IN(24)) { row_phase<false, false, true, false, false>(P, lds, MISC, tid, lane, wave, G, false, NG + 2 * 2048 + 1024, MOD + 2 * 9 * 6144, 3, nullptr, 0, 0); SEAM(24); }
    if (IN(25)) { GEMM_SWIGLU(Wb + W_FFN_GU(1)); SEAM(25); }
    if (IN(26)) { GEMM_RESID(HH, Wb + W_FFN_DN(1), FF, 2, 5, false); SEAM(26); }
    if (IN(27)) { row_phase<false, false, true, false, false>(P, lds, MISC, tid, lane, wave, G, false, NG + 3 * 2048 + 0, MOD + 3 * 9 * 6144, 0, nullptr, 0, 0); SEAM(27); }
    if (IN(28)) { GEMM_BF16(H, Wb + W_MLA_D(1), 768, 1024, DOWN, 768, false); SEAM(28); }
    if (IN(29)) { mla_mid_phase(P, lane, wave, G, 1); SEAM(29); }
    if (IN(30)) { GEMM_BF16(QN, Wb + W_MLA_UQ(1), 1536, 384, QM, 1536, true); GEMM_BF16(CKV, Wb + W_MLA_UKV(1), 2048, 256, KVM, 2048, false); SEAM(30); }
    if (IN(31)) { mla_qpost_phase(P, lane, wave, G); SEAM(31); }
    if (IN(32)) { attn_phase<0>(P, lds, vcu, G, false); SEAM(32); }
    if (IN(33)) { GEMM_RESID(O, Wb + W_MLA_O(1), 1024, 3, 2, true); SEAM(33); }
    if (IN(34)) { row_phase<false, false, true, true, false>(P, lds, MISC, tid, lane, wave, G, true, NG + 3 * 2048 + 1024, MOD + 3 * 9 * 6144, 3, nullptr, 0, 1); SEAM(34); }
    if (IN(35)) { MOE_GU(1); SEAM(35); }
    if (IN(36)) { MOE_DN(1); SEAM(36); }
    if (IN(37)) { row_phase<false, true, false, false, true>(P, lds, MISC, tid, lane, wave, G, true, P.in[I_FNORMG], nullptr, 0, MOD + 3 * 9 * 6144, 1, 0); }
#undef IN
#undef SEAM
}

extern "C" void kernel_launch(void* const* d_in, const int* in_sizes, int n_in, void* d_out, int out_size, void* d_ws, size_t ws_size, hipStream_t stream) {
    static int grid = 0;
    if (grid == 0) {
        if (n_in != N_IN || in_sizes[0] != NB * SEQ * DM || out_size != NB * SEQ * DM || ws_size < WS_END) {
            fprintf(stderr, "kernel_launch: unexpected problem (n_in %d, in0 %d, out %d, ws %zu); nothing launched\n", n_in, n_in > 0 ? in_sizes[0] : -1, out_size, ws_size); grid = -1; return; }
        int dev = 0, cus = 0, per_cu = 0;
        if (hipGetDevice(&dev) != hipSuccess || hipDeviceGetAttribute(&cus, hipDeviceAttributeMultiprocessorCount, dev) != hipSuccess) { grid = -1; return; }
        if (hipFuncSetAttribute((const void*)mk_fwd, hipFuncAttributeMaxDynamicSharedMemorySize, LDS_BYTES) != hipSuccess) { fprintf(stderr, "kernel_launch: hipFuncSetAttribute failed\n"); grid = -1; return; }
        if (hipOccupancyMaxActiveBlocksPerMultiprocessor(&per_cu, (const void*)mk_fwd, 512, LDS_BYTES) != hipSuccess || per_cu < 1)
            fprintf(stderr, "kernel_launch: note: occupancy query reports %d workgroups per CU\n", per_cu);
        (void)hipGetLastError();
        grid = cus;
    }
    if (grid < 0) return;
    if (hipMemsetAsync((char*)d_ws + WS_CTL, 0, CTL_ZERO_BYTES, stream) != hipSuccess) return;
    Params p{};
    for (int i = 0; i < N_IN; ++i) p.in[i] = (const float*)d_in[i];
    p.out = (float*)d_out; p.ws = (unsigned char*)d_ws;
#if MK_SPLIT
    for (int ph = 0; ph < N_PHASES; ++ph) { p.ph_lo = ph; p.ph_hi = ph + 1; hipLaunchKernelGGL(mk_fwd, dim3(grid), dim3(512), LDS_BYTES, stream, p); }
#else
    p.ph_lo = 0; p.ph_hi = N_PHASES;
    hipLaunchKernelGGL(mk_fwd, dim3(grid), dim3(512), LDS_BYTES, stream, p);
#endif
}
```

```cpp
#include <hip/hip_runtime.h>
#include <cstdio>
#include <cstdint>

#define GAS __attribute__((address_space(1)))
#define LAS __attribute__((address_space(3)))
typedef unsigned short bf16;
typedef short bf16x8 __attribute__((ext_vector_type(8)));
typedef short s16x4 __attribute__((ext_vector_type(4)));
typedef float f32x4 __attribute__((ext_vector_type(4)));
typedef float f32x2 __attribute__((ext_vector_type(2)));
typedef float f32x16 __attribute__((ext_vector_type(16)));
typedef unsigned u32x4 __attribute__((ext_vector_type(4)));
typedef unsigned u32x2 __attribute__((ext_vector_type(2)));
typedef int i32x4 __attribute__((ext_vector_type(4)));
typedef GAS unsigned gu32;

#ifndef MK_SPLIT
#define MK_SPLIT 0
#endif

constexpr int NB = 8, SEQ = 2048, CTXL = 256, DM = 1024, RPB = SEQ + CTXL  , T = NB * RPB  , NPAN = T / 256  ;
constexpr int NHEAD = 16, FF = 2816, EFF = 1408, NEXP = 8;
constexpr int MAXR = 2 * T + NEXP * 256;
constexpr float LOG2E = 1.4426950408889634f;
constexpr float NORM_EPS = 1e-6f;
constexpr float QS64 = 0.125f * LOG2E;
constexpr float QS96 = 0.10206207261596577f * LOG2E;

enum { I_X = 0, I_C, I_CTX, I_CCTX, I_ADAW, I_ADAB, I_NORMG, I_FNORMG, I_MLA_DQ, I_MLA_QNG, I_MLA_UQ, I_MLA_DKV, I_MLA_KVNG, I_MLA_UKV, I_MLA_O,
       I_SWA_QKV, I_SWA_SINK, I_SWA_O, I_GA_QKV, I_GA_QNG, I_GA_KNG, I_GA_O, I_FFN_GU, I_FFN_DN, I_MOE_RW, I_MOE_RB, I_MOE_GU, I_MOE_DN, N_IN };

constexpr size_t WSZ_D = 768 * 1024, WSZ_UQ = 1536 * 384, WSZ_UKV = 2048 * 256, WSZ_O = 1024 * 1024;
constexpr size_t MLA_SZ = WSZ_D + WSZ_UQ + WSZ_UKV + WSZ_O;
constexpr size_t W_MLA_D(int j) { return j * MLA_SZ; }
constexpr size_t W_MLA_UQ(int j) { return j * MLA_SZ + WSZ_D; }
constexpr size_t W_MLA_UKV(int j) { return j * MLA_SZ + WSZ_D + WSZ_UQ; }
constexpr size_t W_MLA_O(int j) { return j * MLA_SZ + WSZ_D + WSZ_UQ + WSZ_UKV; }
constexpr size_t W_SWA_QKV = 2 * MLA_SZ, W_SWA_O = W_SWA_QKV + 1536 * 1024;
constexpr size_t W_GA_QKV = W_SWA_O + WSZ_O, W_GA_O = W_GA_QKV + 2048 * 1024;
constexpr size_t W_FFN0 = W_GA_O + WSZ_O, FFN_GU_SZ = (size_t)2 * FF * 1024, FFN_DN_SZ = (size_t)1024 * FF, FFN_SZ = FFN_GU_SZ + FFN_DN_SZ;
constexpr size_t W_FFN_GU(int f) { return W_FFN0 + f * FFN_SZ; }
constexpr size_t W_FFN_DN(int f) { return W_FFN0 + f * FFN_SZ + FFN_GU_SZ; }
constexpr size_t W_MOE0 = W_FFN0 + 2 * FFN_SZ, MOE_GU_SZ = (size_t)2 * EFF * 1024, MOE_DN_SZ = (size_t)1024 * EFF, MOE_SZ = NEXP * (MOE_GU_SZ + MOE_DN_SZ);
constexpr size_t W_MOE_GU(int f) { return W_MOE0 + f * MOE_SZ; }
constexpr size_t W_MOE_DN(int f) { return W_MOE0 + f * MOE_SZ + NEXP * MOE_GU_SZ; }
constexpr size_t W_TOTAL = W_MOE0 + 2 * MOE_SZ;
static_assert(W_TOTAL == 98172928, "weight map");

constexpr size_t MiB = 1u << 20;
constexpr size_t WS_CTL = 0, CTL_ZERO_BYTES = 1 * MiB;
constexpr size_t WS_MOD = 1 * MiB;
constexpr size_t WS_LIST = 2 * MiB;
constexpr size_t WS_INFO = 4 * MiB;
constexpr size_t WS_W = 8 * MiB;
constexpr size_t WS_X = 200 * MiB;
constexpr size_t WS_H = 272 * MiB;
constexpr size_t WS_O = 308 * MiB;
constexpr size_t WS_S = 344 * MiB;
constexpr size_t WS_END = 528 * MiB;
static_assert(WS_W + W_TOTAL * 2 <= WS_X, "weights fit");
constexpr size_t S_QKV = 0;
constexpr size_t S_DOWN = 0;
constexpr size_t S_QN = 27 * MiB;
constexpr size_t S_CKV = 41 * MiB;
constexpr size_t S_KR = 50 * MiB;
constexpr size_t S_QM = 52 * MiB;
constexpr size_t S_KVM = 106 * MiB;
constexpr size_t S_HH = 0;
constexpr size_t S_HS = 0;
constexpr size_t S_YS = 106 * MiB;
static_assert(S_KVM + (size_t)T * 2048 * 2 <= WS_END - WS_S && S_YS + (size_t)MAXR * 1024 * 2 <= WS_END - WS_S && (size_t)MAXR * EFF * 2 <= S_YS, "scratch map");
constexpr int CW_TMO = 0, CW_CODE = 1;
constexpr int CW_BAR = 4096;
constexpr int CW_CNT = 16384;

constexpr int RING_OFF = 0, RING_BYTES = 131072;
constexpr int MISC_OFF = RING_BYTES;
constexpr int LDS_BYTES = 147456;
constexpr int MW_CNT = 32, MW_OFF = 40, MW_NP = 48, MW_TAB = 64;

#define RLX_AGENT __ATOMIC_RELAXED, __HIP_MEMORY_SCOPE_AGENT
#define LDS_WAIT() asm volatile("s_waitcnt lgkmcnt(0)" ::: "memory")
#define VM_WAIT() asm volatile("s_waitcnt vmcnt(0)" ::: "memory")
__device__ __forceinline__ unsigned cvt_pk_bf16(float lo, float hi) { unsigned r; asm volatile("v_cvt_pk_bf16_f32 %0, %1, %2" : "=v"(r) : "v"(lo), "v"(hi)); return r; }
__device__ __forceinline__ float bf_lo(unsigned u) { return __uint_as_float(u << 16); }
__device__ __forceinline__ float bf_hi(unsigned u) { return __uint_as_float(u & 0xffff0000u); }
__device__ __forceinline__ float wave_sum(float v) {
#pragma unroll
    for (int o = 1; o < 64; o <<= 1) v += __shfl_xor(v, o);
    return v;
}
__device__ __forceinline__ float fast_exp2(float x) { return __builtin_amdgcn_exp2f(x); }
__device__ __forceinline__ float fast_rcp(float x) { return __builtin_amdgcn_rcpf(x); }
__device__ __forceinline__ void sincos_rad(float a, float& s, float& c) { float r = a * 0.15915494309189535f; r = r - floorf(r); s = __builtin_amdgcn_sinf(r); c = __builtin_amdgcn_cosf(r); }

namespace pg8 {
constexpr int BM = 256, BK = 64, HALF = 128, HTB = HALF * BK * 2, STAGE_BYTES = 8 * HTB, NXCD = 8, WGM = 8;
__host__ __device__ __forceinline__ int lds_byte(int r, int c) { const int st = (r >> 4) * 2 + (c >> 5), rr = r & 15, cc = c & 31, ob = rr * 64 + cc * 2; return st * 1024 + (ob ^ (((ob >> 9) & 1) << 5)); }
__host__ __device__ __forceinline__ void stage_rc(int b, int& R, int& C) { const int st = b / 1024, sb = b % 1024, swz = sb ^ (((sb >> 9) & 1) << 5); R = (st >> 1) * 16 + swz / 64; C = (st & 1) * 32 + (swz % 64) / 2; }
__host__ __device__ __forceinline__ int perm32(int rho) { const int n = rho >> 4, i = rho & 15; return 8 * (i >> 2) + 4 * n + (i & 3); }

struct Unit { int pm, pn, arow, eb, nvalid; const int* list; };
struct Gemm { const bf16* A; const bf16* Bt; int N, K; };

struct DenseOrder {
    int nM, nN, nwg, G, c, lat;
    __device__ __forceinline__ void init(int nM_, int nN_, int G_, int c_, int lat_) { nM = nM_; nN = nN_; nwg = nM * nN; G = G_; c = c_; lat = lat_; }
    __device__ __forceinline__ bool next(int i, Unit& u) const {
        const long L = (long)i * G + c; if (L >= nwg) return false;
        int wgid = (int)L; { const int q = nwg / NXCD, r = nwg % NXCD, xcd = wgid % NXCD, off = wgid / NXCD; wgid = (xcd < r ? xcd * (q + 1) : r * (q + 1) + (xcd - r) * q) + off; }
        const int nig = WGM * nN, gid = wgid / nig, fm = gid * WGM, gsz = (nM - fm) < WGM ? (nM - fm) : WGM;
        int pm = fm + ((wgid % nig) % gsz); u.pn = (wgid % nig) / gsz;
        if (lat) pm = (pm >> 3) * 9 + 1 + (pm & 7);
        u.pm = pm; u.arow = pm * BM; u.eb = 0; u.nvalid = BM; u.list = nullptr; return true;
    }
};
struct MoeOrder {
    volatile LAS unsigned* misc; const int* lists; int nN, G, c, gather;
    __device__ __forceinline__ bool next(int i, Unit& u) const {
        const int NP = __builtin_amdgcn_readfirstlane((int)misc[MW_NP]); const long L = (long)i * G + c; if (L >= (long)NP * nN) return false;
        const int p = (int)(L / nN); u.pn = (int)(L % nN);
        const unsigned tv = (unsigned)__builtin_amdgcn_readfirstlane((int)misc[MW_TAB + p]); const int e = (int)(tv >> 16), lp = (int)(tv & 0xffffu);
        u.pm = p; u.arow = p * BM; u.eb = e; u.nvalid = __builtin_amdgcn_readfirstlane((int)misc[MW_CNT + e]) - lp * BM; u.list = lists + (size_t)e * T + lp * BM; return true;
    }
};

struct EpiBf16 {
    static constexpr bool PERM = true;
    bf16* O; int ldc;
    __device__ __forceinline__ void operator()(const f32x4 (&acc)[2][2][4][2], const Unit& u, int wr, int wc, int fr, int fq) const {
        const int row0 = u.pm * BM + wr * 64 + fr; const int col0 = u.pn * BM + wc * 32 + 8 * fq;
#pragma unroll
        for (int ai = 0; ai < 2; ++ai)
#pragma unroll
            for (int m = 0; m < 4; ++m) { bf16* rowp = O + (size_t)(row0 + ai * HALF + m * 16) * ldc + col0;
#pragma unroll
                for (int bj = 0; bj < 2; ++bj) { const f32x4 v0 = acc[ai][bj][m][0], v1 = acc[ai][bj][m][1];
                    u32x4 w; w.x = cvt_pk_bf16(v0[0], v0[1]); w.y = cvt_pk_bf16(v0[2], v0[3]); w.z = cvt_pk_bf16(v1[0], v1[1]); w.w = cvt_pk_bf16(v1[2], v1[3]);
                    *(u32x4*)(rowp + bj * HALF) = w; } }
    }
};
struct EpiSwiglu {
    static constexpr bool PERM = true;
    bf16* O; int ldc;
    __device__ __forceinline__ void operator()(const f32x4 (&acc)[2][2][4][2], const Unit& u, int wr, int wc, int fr, int fq) const {
        const int row0 = u.pm * BM + wr * 64 + fr; const int col0 = u.pn * HALF + wc * 32 + 8 * fq;
#pragma unroll
        for (int ai = 0; ai < 2; ++ai)
#pragma unroll
            for (int m = 0; m < 4; ++m) { bf16* rowp = O + (size_t)(row0 + ai * HALF + m * 16) * ldc + col0; float o[8];
#pragma unroll
                for (int n = 0; n < 2; ++n)
#pragma unroll
                    for (int e = 0; e < 4; ++e) { const float g = acc[ai][0][m][n][e], up = acc[ai][1][m][n][e];
                        o[n * 4 + e] = g * up * fast_rcp(1.0f + fast_exp2(-g * LOG2E)); }
                u32x4 w; w.x = cvt_pk_bf16(o[0], o[1]); w.y = cvt_pk_bf16(o[2], o[3]); w.z = cvt_pk_bf16(o[4], o[5]); w.w = cvt_pk_bf16(o[6], o[7]);
                *(u32x4*)rowp = w; }
    }
};
struct EpiResid {
    static constexpr bool PERM = false;
    float* X; const float* gates;
    __device__ __forceinline__ void operator()(const f32x4 (&acc)[2][2][4][2], const Unit& u, int wr, int wc, int fr, int fq) const {
        const int b = u.pm / 9, mi = (u.pm - b * 9 == 0) ? 8 : b;
        const int col0 = u.pn * BM + wc * 32 + 4 * fq; const float* gp = gates + (size_t)mi * 6144 + col0;
        f32x4 gv[2][2];
#pragma unroll
        for (int bj = 0; bj < 2; ++bj)
#pragma unroll
            for (int n = 0; n < 2; ++n) gv[bj][n] = *(const f32x4*)(gp + bj * HALF + n * 16);
#pragma unroll
        for (int ai = 0; ai < 2; ++ai)
#pragma unroll
            for (int m = 0; m < 4; ++m) { float* rowp = X + (size_t)(u.pm * BM + ai * HALF + wr * 64 + m * 16 + fr) * DM + col0;
#pragma unroll
                for (int bj = 0; bj < 2; ++bj)
#pragma unroll
                    for (int n = 0; n < 2; ++n) { f32x4* p = (f32x4*)(rowp + bj * HALF + n * 16); const f32x4 xv = *p; *p = xv + gv[bj][n] * acc[ai][bj][m][n]; }
                if (m & 1) asm volatile("" ::: "memory"); }
    }
};

template <class Epi, class Sched, bool GATHER>
__device__ __forceinline__ void gemm_phase(LAS unsigned char* lds, const Gemm g, const Sched& S, const Epi& E) {
    const int tid = threadIdx.x, wid = __builtin_amdgcn_readfirstlane(tid >> 6), lane = tid & 63, wr = wid >> 2, wc = wid & 3, fr = lane & 15, fq = lane >> 4;
    const int K = g.K, nt = K / BK;
    unsigned voffB[2], c2[2]; int rr[2];
#pragma unroll
    for (int i = 0; i < 2; ++i) { int R, C; stage_rc(tid * 16 + i * 8192, R, C); const int Rb = Epi::PERM ? ((R & ~31) + perm32(R & 31)) : R;
        voffB[i] = (unsigned)(Rb * K + C) * 2u; rr[i] = R; c2[i] = (unsigned)C * 2u; }
    const size_t kstep = (size_t)(BK * 2);
    const size_t hstep = (size_t)HALF * K * 2;
    const unsigned ldsw = (unsigned)wid * 1024u;
    const int aoff = lds_byte(wr * 64 + fr, fq * 8), boff = lds_byte(wc * 32 + fr, fq * 8);
    unsigned vAc[2][2], vAn[2][2];
#define PG8_SA(b, h) (((b) * 2 + (h)) * HTB)
#define PG8_SB(b, h) ((4 + (b) * 2 + (h)) * HTB)
#define PG8_STAGE_B(bufoff, gbase) do { _Pragma("unroll") for (int _i = 0; _i < 2; ++_i) \
        __builtin_amdgcn_global_load_lds((const unsigned*)((const char*)(gbase) + voffB[_i]), (LAS unsigned*)(lds + (bufoff) + ldsw + _i * 8192), 16, 0, 0); } while (0)
#define PG8_STAGE_A(bufoff, gbase, V, h) do { _Pragma("unroll") for (int _i = 0; _i < 2; ++_i) \
        __builtin_amdgcn_global_load_lds((const unsigned*)((const char*)(gbase) + (V)[h][_i]), (LAS unsigned*)(lds + (bufoff) + ldsw + _i * 8192), 16, 0, 0); } while (0)
#define PG8_LDA(dst, b, h) do { _Pragma("unroll") for (int m = 0; m < 4; ++m) _Pragma("unroll") for (int k = 0; k < 2; ++k) dst[m][k] = *(const LAS bf16x8*)(lds + PG8_SA(b, h) + aoff + m * 2048 + k * 1024); } while (0)
#define PG8_LDB(dst, b, h) do { _Pragma("unroll") for (int n = 0; n < 2; ++n) _Pragma("unroll") for (int k = 0; k < 2; ++k) dst[n][k] = *(const LAS bf16x8*)(lds + PG8_SB(b, h) + boff + n * 2048 + k * 1024); } while (0)
#define PG8_MMA(ai, bj, At, Bt) do { __builtin_amdgcn_s_setprio(1); _Pragma("unroll") for (int m = 0; m < 4; ++m) _Pragma("unroll") for (int n = 0; n < 2; ++n) _Pragma("unroll") for (int k = 0; k < 2; ++k) \
        acc[ai][bj][m][n] = __builtin_amdgcn_mfma_f32_16x16x32_bf16(Bt[n][k], At[m][k], acc[ai][bj][m][n], 0, 0, 0); __builtin_amdgcn_s_setprio(0); } while (0)
#define PG8_WAIT_V(n) asm volatile("s_waitcnt vmcnt(" #n ")" ::: "memory")
#define PG8_WAIT_L(n) asm volatile("s_waitcnt lgkmcnt(" #n ")" ::: "memory")
#define PG8_BAR __builtin_amdgcn_s_barrier()
#define PG8_SCHED __builtin_amdgcn_sched_barrier(0)
#define PG8_SETV(V, U) do { _Pragma("unroll") for (int _h = 0; _h < 2; ++_h) _Pragma("unroll") for (int _i = 0; _i < 2; ++_i) { \
        if constexpr (GATHER) { const int _r = _h * HALF + rr[_i]; const int _tok = (_r < (U).nvalid) ? (U).list[_r] : 0; (V)[_h][_i] = (unsigned)_tok * (unsigned)(K * 2) + c2[_i]; } \
        else (V)[_h][_i] = (unsigned)((_h * HALF + rr[_i]) * K) * 2u + c2[_i]; } } while (0)
    Unit cur, nxt; int ui = 0;
    if (!S.next(0, cur)) return;
    f32x4 acc[2][2][4][2];
#pragma unroll
    for (int a = 0; a < 2; ++a)
#pragma unroll
        for (int b = 0; b < 2; ++b)
#pragma unroll
            for (int m = 0; m < 4; ++m)
#pragma unroll
                for (int n = 0; n < 2; ++n) acc[a][b][m][n] = (f32x4){0.f, 0.f, 0.f, 0.f};
    bf16x8 At[4][2], B0[2][2], B1[2][2];
    PG8_SETV(vAc, cur);
    const char* cA = (const char*)g.A + (GATHER ? (size_t)0 : (size_t)cur.arow * K * 2);
    const char* cB = (const char*)g.Bt + ((size_t)cur.eb * g.N + (size_t)cur.pn * BM) * K * 2;
    PG8_STAGE_B(PG8_SB(0, 0), cB); PG8_STAGE_B(PG8_SB(0, 1), cB + hstep); PG8_STAGE_A(PG8_SA(0, 0), cA, vAc, 0); PG8_STAGE_A(PG8_SA(0, 1), cA, vAc, 1);
    if (wr == 1) PG8_BAR;
    PG8_WAIT_V(2); PG8_BAR;
    PG8_STAGE_B(PG8_SB(1, 0), cB + kstep); PG8_STAGE_A(PG8_SA(1, 0), cA + kstep, vAc, 0); PG8_STAGE_B(PG8_SB(1, 1), cB + hstep + kstep);
    PG8_WAIT_V(6); PG8_BAR;
    for (;;) {
        const bool has_next = S.next(ui + 1, nxt);
        const char* nA = cA; const char* nB = cB;
        if (has_next) { nA = (const char*)g.A + (GATHER ? (size_t)0 : (size_t)nxt.arow * K * 2); nB = (const char*)g.Bt + ((size_t)nxt.eb * g.N + (size_t)nxt.pn * BM) * K * 2; }
        if constexpr (GATHER) { if (has_next) PG8_SETV(vAn, nxt); else { _Pragma("unroll") for (int _h = 0; _h < 2; ++_h) _Pragma("unroll") for (int _i = 0; _i < 2; ++_i) vAn[_h][_i] = vAc[_h][_i]; } }
        for (int t = 0; t < nt; t += 2) {
            const bool last = (t == nt - 2);
            const char* a1 = cA + (size_t)(t + 1) * kstep;
            const char* a2 = last ? nA : cA + (size_t)(t + 2) * kstep; const char* b2 = last ? nB : cB + (size_t)(t + 2) * kstep;
            const char* a3 = a2 + kstep; const char* b3 = b2 + kstep;
            unsigned v2[2][2];
#pragma unroll
            for (int _h = 0; _h < 2; ++_h)
#pragma unroll
                for (int _i = 0; _i < 2; ++_i) v2[_h][_i] = (GATHER && last) ? vAn[_h][_i] : vAc[_h][_i];
            PG8_LDB(B0, 0, 0); PG8_LDB(B1, 0, 1); PG8_SCHED; PG8_LDA(At, 0, 0); PG8_STAGE_A(PG8_SA(1, 1), a1, vAc, 1);
            PG8_WAIT_V(8); PG8_WAIT_L(0); PG8_BAR; PG8_MMA(0, 0, At, B0); PG8_MMA(0, 1, At, B1); PG8_BAR; PG8_SCHED;
            PG8_LDA(At, 0, 1); PG8_STAGE_B(PG8_SB(0, 0), b2); PG8_STAGE_B(PG8_SB(0, 1), b2 + hstep); PG8_STAGE_A(PG8_SA(0, 0), a2, v2, 0);
            PG8_WAIT_V(8); PG8_WAIT_L(0); PG8_BAR; PG8_MMA(1, 0, At, B0); PG8_MMA(1, 1, At, B1); PG8_BAR; PG8_SCHED;
            PG8_LDB(B0, 1, 0); PG8_LDB(B1, 1, 1); PG8_SCHED; PG8_LDA(At, 1, 0); PG8_STAGE_A(PG8_SA(0, 1), a2, v2, 1);
            PG8_WAIT_V(8); PG8_WAIT_L(0); PG8_BAR; PG8_MMA(0, 0, At, B0); PG8_MMA(0, 1, At, B1); PG8_BAR; PG8_SCHED;
            PG8_LDA(At, 1, 1); PG8_STAGE_B(PG8_SB(1, 0), b3); PG8_STAGE_B(PG8_SB(1, 1), b3 + hstep); PG8_STAGE_A(PG8_SA(1, 0), a3, v2, 0);
            PG8_WAIT_V(8); PG8_WAIT_L(0); PG8_BAR; PG8_MMA(1, 0, At, B0); PG8_MMA(1, 1, At, B1); PG8_BAR; PG8_SCHED;
        }
        if (wr == 0) PG8_BAR;
        E(acc, cur, wr, wc, fr, fq);
        if (!has_next) break;
#pragma unroll
        for (int a = 0; a < 2; ++a)
#pragma unroll
            for (int b = 0; b < 2; ++b)
#pragma unroll
                for (int m = 0; m < 4; ++m)
#pragma unroll
                    for (int n = 0; n < 2; ++n) acc[a][b][m][n] = (f32x4){0.f, 0.f, 0.f, 0.f};
        cur = nxt; cA = nA; cB = nB; ++ui;
        if constexpr (GATHER) { _Pragma("unroll") for (int _h = 0; _h < 2; ++_h) _Pragma("unroll") for (int _i = 0; _i < 2; ++_i) vAc[_h][_i] = vAn[_h][_i]; }
        if (wr == 1) PG8_BAR;
    }
    PG8_WAIT_V(0);
    PG8_BAR;
#undef PG8_SA
#undef PG8_SB
#undef PG8_STAGE_A
#undef PG8_STAGE_B
#undef PG8_LDA
#undef PG8_LDB
#undef PG8_MMA
#undef PG8_WAIT_V
#undef PG8_WAIT_L
#undef PG8_BAR
#undef PG8_SCHED
#undef PG8_SETV
}
}

namespace att {
__device__ __forceinline__ int crow(int r, int hi) { return (r & 3) + 8 * (r >> 2) + 4 * hi; }
__device__ __forceinline__ void glds16(const void* gsrc, unsigned lds_dst) { unsigned keep;
    asm volatile("s_mov_b32 %0, m0\n\ts_mov_b32 m0, %2\n\ts_nop 0\n\tglobal_load_lds_dwordx4 %1, off\n\ts_mov_b32 m0, %0" : "=&s"(keep) : "v"(gsrc), "s"(lds_dst) : "memory"); }
typedef short v4i16_t __attribute__((ext_vector_type(4)));
__device__ __forceinline__ s16x4 vtr(const LAS char* p) { return __builtin_bit_cast(s16x4, __builtin_amdgcn_ds_read_tr16_b64_v4i16((LAS v4i16_t*)p)); }
constexpr float THR = 8.0f;
constexpr float NEGB = -1.0e30f;

template <int DQK, int WINDOW, int SINK>
__device__ __forceinline__ void attn_unit(const bf16* Qb, int ldq, const bf16* K1, int ldk1, const bf16* K2, int ldk2, const bf16* Vb, int ldv, bf16* Ob, int ldo,
                                          int qb, float sink_l2, LAS char* shm) {
    constexpr int NKD = DQK / 16, KSLOT = DQK * 128, VSLOT = 8192;
    constexpr int LDS_K = 0, LDS_V = 3 * KSLOT, LDS_WS = LDS_V + 3 * VSLOT, LDS_OST = LDS_WS + 8 * 64 * 4;
    static_assert(LDS_OST + 8 * 4096 <= RING_BYTES, "attention LDS");
    const int tid = threadIdx.x, lane = tid & 63, r32 = lane & 31, hi = lane >> 5; const int wid = __builtin_amdgcn_readfirstlane(tid >> 6);
    const unsigned lds0 = (unsigned)(uintptr_t)shm;
    LAS float* wsf = (LAS float*)(shm + LDS_WS) + wid * 64;
    int NT, lt0 = 0;
    if (qb == 0) NT = 4;
    else if (!WINDOW) NT = 36;
    else { const int q0l = 256 * (qb - 1); const int lo = (q0l >= 128 ? q0l - 128 : 0) >> 6; const int hi_t = ((q0l + 383) < 2047 ? (q0l + 383) : 2047) >> 6; lt0 = lo; NT = 4 + hi_t - lo + 1; }
    const bool dma2 = (DQK == 96) && (wid < 4);
#define KROW(j) (((j) < 4) ? 64 * (j) : 256 + 64 * (lt0 + (j) - 4))
#define ISSUE(j, sl) do { const int kr_ = KROW(j); \
        glds16(K1 + (long)(kr_ + lane) * ldk1 + wid * 8, (unsigned)__builtin_amdgcn_readfirstlane(lds0 + LDS_K + (sl) * KSLOT + wid * 1024)); \
        if (dma2) glds16(K2 + (long)(kr_ + lane) * ldk2 + wid * 8, (unsigned)__builtin_amdgcn_readfirstlane(lds0 + LDS_K + (sl) * KSLOT + (8 + wid) * 1024)); \
        glds16(Vb + (long)(kr_ + 16 * (wid & 3) + (lane >> 2)) * ldv + (wid >> 2) * 32 + (lane & 3) * 8, (unsigned)__builtin_amdgcn_readfirstlane(lds0 + LDS_V + (sl) * VSLOT + wid * 1024)); } while (0)
    ISSUE(0, 0); ISSUE(1, 1);
    const bf16* Qw = Qb + (long)(256 * qb + 32 * wid + r32) * ldq + hi * 8;
    bf16x8 qr[NKD];
#pragma unroll
    for (int d0 = 0; d0 < NKD; ++d0) qr[d0] = *reinterpret_cast<const bf16x8*>(Qw + d0 * 16);
    float m_run = NEGB, l_run = 0.f; f32x16 o[2];
#pragma unroll
    for (int r = 0; r < 16; ++r) { o[0][r] = 0.f; o[1][r] = 0.f; }
    const int qw = 256 * (qb - 1) + 32 * wid;
    int sl = 0;
    for (int j = 0; j < NT; ++j) {
        if (j + 1 < NT) { if (dma2) asm volatile("s_waitcnt vmcnt(3) lgkmcnt(0)\n\ts_barrier" ::: "memory"); else asm volatile("s_waitcnt vmcnt(2) lgkmcnt(0)\n\ts_barrier" ::: "memory"); }
        else asm volatile("s_waitcnt vmcnt(0) lgkmcnt(0)\n\ts_barrier" ::: "memory");
        if (j + 2 < NT) { const int s2 = (sl >= 1) ? sl - 1 : 2; ISSUE(j + 2, s2); }
        const int slc = sl; sl = (sl == 2) ? 0 : sl + 1;
        int mode = 0;
        int k0 = 0;
        if (WINDOW && qb > 0 && j >= 4) { k0 = 64 * (lt0 + j - 4);
            if (k0 + 63 < qw - 128 || k0 > qw + 31 + 128) mode = 2; else if (!(k0 >= qw + 31 - 128 && k0 + 63 <= qw + 128)) mode = 1; }
        if (mode == 2) continue;
        f32x16 p0, p1;
#pragma unroll
        for (int r = 0; r < 16; ++r) { p0[r] = 0.f; p1[r] = 0.f; }
        { const LAS char* kb = shm + LDS_K + slc * KSLOT + hi * 1024 + r32 * 16;
#pragma unroll
          for (int d0 = 0; d0 < NKD; ++d0) { const bf16x8 b0 = *(const LAS bf16x8*)(kb + d0 * 2048); const bf16x8 b1 = *(const LAS bf16x8*)(kb + d0 * 2048 + 512);
              p0 = __builtin_amdgcn_mfma_f32_32x32x16_bf16(b0, qr[d0], p0, 0, 0, 0); p1 = __builtin_amdgcn_mfma_f32_32x32x16_bf16(b1, qr[d0], p1, 0, 0, 0); } }
        if (WINDOW && mode == 1) { const int q = qw + r32;
#pragma unroll
            for (int r = 0; r < 16; ++r) { const int kv = k0 + crow(r, hi); int d0_ = q - kv; d0_ = d0_ < 0 ? -d0_ : d0_; int d1_ = q - kv - 32; d1_ = d1_ < 0 ? -d1_ : d1_;
                if (d0_ > 128) p0[r] = NEGB; if (d1_ > 128) p1[r] = NEGB; } }
        float rm = p0[0];
#pragma unroll
        for (int r = 1; r < 16; ++r) rm = fmaxf(rm, p0[r]);
#pragma unroll
        for (int r = 0; r < 16; ++r) rm = fmaxf(rm, p1[r]);
        { auto rrv = __builtin_amdgcn_permlane32_swap(__float_as_uint(rm), __float_as_uint(rm), false, false); rm = fmaxf(__uint_as_float(rrv[0]), __uint_as_float(rrv[1])); }
        if (__any(rm > m_run + THR)) {
            const float mn = fmaxf(m_run, rm); const float al = fast_exp2(m_run - mn); m_run = mn; l_run *= al;
            if (hi == 0) wsf[r32] = al;
            LDS_WAIT();
#pragma unroll
            for (int r = 0; r < 16; ++r) { const float f = wsf[crow(r, hi)]; o[0][r] *= f; o[1][r] *= f; }
        }
        float ps = 0.f;
#pragma unroll
        for (int r = 0; r < 16; ++r) { p0[r] = fast_exp2(p0[r] - m_run); p1[r] = fast_exp2(p1[r] - m_run); ps += p0[r] + p1[r]; }
        l_run += ps;
        u32x4 pw0, pw1, pw2, pw3;
        pw0 = (u32x4){cvt_pk_bf16(p0[0], p0[1]), cvt_pk_bf16(p0[2], p0[3]), cvt_pk_bf16(p0[4], p0[5]), cvt_pk_bf16(p0[6], p0[7])};
        pw1 = (u32x4){cvt_pk_bf16(p0[8], p0[9]), cvt_pk_bf16(p0[10], p0[11]), cvt_pk_bf16(p0[12], p0[13]), cvt_pk_bf16(p0[14], p0[15])};
        pw2 = (u32x4){cvt_pk_bf16(p1[0], p1[1]), cvt_pk_bf16(p1[2], p1[3]), cvt_pk_bf16(p1[4], p1[5]), cvt_pk_bf16(p1[6], p1[7])};
        pw3 = (u32x4){cvt_pk_bf16(p1[8], p1[9]), cvt_pk_bf16(p1[10], p1[11]), cvt_pk_bf16(p1[12], p1[13]), cvt_pk_bf16(p1[14], p1[15])};
        const bf16x8 pa[4] = {__builtin_bit_cast(bf16x8, pw0), __builtin_bit_cast(bf16x8, pw1), __builtin_bit_cast(bf16x8, pw2), __builtin_bit_cast(bf16x8, pw3)};
        { const LAS char* vp = shm + LDS_V + slc * VSLOT + ((lane >> 4) & 1) * 32 + (lane & 3) * 8 + (4 * hi + ((lane & 15) >> 2)) * 64;
#pragma unroll
          for (int d0 = 0; d0 < 2; ++d0)
#pragma unroll
              for (int ks = 0; ks < 4; ++ks) { const s16x4 lo = vtr(vp + d0 * 4096 + ks * 1024), hh = vtr(vp + d0 * 4096 + ks * 1024 + 512);
                  const bf16x8 vf = (bf16x8){lo[0], lo[1], lo[2], lo[3], hh[0], hh[1], hh[2], hh[3]};
                  o[d0] = __builtin_amdgcn_mfma_f32_32x32x16_bf16(pa[ks], vf, o[d0], 0, 0, 0); } }
    }
    { auto rrv = __builtin_amdgcn_permlane32_swap(__float_as_uint(l_run), __float_as_uint(l_run), false, false); l_run = __uint_as_float(rrv[0]) + __uint_as_float(rrv[1]); }
    if (SINK) l_run += fast_exp2(sink_l2 - m_run);
    if (hi == 0) wsf[32 + r32] = l_run;
    LDS_WAIT();
    float rli[16];
#pragma unroll
    for (int r = 0; r < 16; ++r) rli[r] = fast_rcp(wsf[32 + crow(r, hi)]);
    bf16* Ow = Ob + (long)(256 * qb + 32 * wid) * ldo;
    { LAS bf16* stg = (LAS bf16*)(shm + LDS_OST) + wid * 2048;
#pragma unroll
      for (int r = 0; r < 16; ++r) { const int orow = crow(r, hi);
#pragma unroll
          for (int d0 = 0; d0 < 2; ++d0) { const unsigned w = cvt_pk_bf16(o[d0][r] * rli[r], 0.f); stg[orow * 64 + d0 * 32 + r32] = (bf16)(w & 0xffffu); } }
      LDS_WAIT();
#pragma unroll
      for (int i = 0; i < 4; ++i) { const int row = i * 8 + (lane >> 3), ch = lane & 7; const u32x4 v = *(const LAS u32x4*)(stg + row * 64 + ch * 8); *(u32x4*)(Ow + (long)row * ldo + ch * 8) = v; } }
    asm volatile("s_waitcnt lgkmcnt(0)\n\ts_barrier" ::: "memory");
#undef KROW
#undef ISSUE
}
}

struct WDesc { int in_idx; unsigned src_off; int ldw, K, N; unsigned dst_off; int row_off, mode, F; float scale; int scale_cols; int item0; };
constexpr int N_WDESC = 50;
struct WTab { WDesc d[N_WDESC]; int n; int total; };
constexpr WTab make_wtab() {
    WTab t{}; int n = 0; int items = 0;
    auto add = [&](int in_idx, size_t src_off, int ldw, int K, int N, size_t dst_off, int row_off, int mode, int F, float scale, int scale_cols) {
        t.d[n] = WDesc{in_idx, (unsigned)src_off, ldw, K, N, (unsigned)dst_off, row_off, mode, F, scale, scale_cols, items}; items += (K / 64) * (N / 32); ++n; };
    for (int j = 0; j < 2; ++j) {
        add(I_MLA_DQ, (size_t)j * 1024 * 384, 384, 1024, 384, W_MLA_D(j), 0, 0, 0, 1.f, 0);
        add(I_MLA_DKV, (size_t)j * 1024 * 288, 288, 1024, 288, W_MLA_D(j), 384, 0, 0, 1.f, 0);
        add(I_MLA_UQ, (size_t)j * 384 * 1536, 1536, 384, 1536, W_MLA_UQ(j), 0, 0, 0, QS96, 1536);
        add(I_MLA_UKV, (size_t)j * 256 * 2048, 2048, 256, 2048, W_MLA_UKV(j), 0, 0, 0, 1.f, 0);
        add(I_MLA_O, (size_t)j * 1024 * 1024, 1024, 1024, 1024, W_MLA_O(j), 0, 0, 0, 1.f, 0);
    }
    add(I_SWA_QKV, 0, 1536, 1024, 1536, W_SWA_QKV, 0, 0, 0, QS64, 1024);
    add(I_SWA_O, 0, 1024, 1024, 1024, W_SWA_O, 0, 0, 0, 1.f, 0);
    add(I_GA_QKV, 0, 2048, 1024, 2048, W_GA_QKV, 0, 0, 0, 1.f, 0);
    add(I_GA_O, 0, 1024, 1024, 1024, W_GA_O, 0, 0, 0, 1.f, 0);
    for (int f = 0; f < 2; ++f) {
        add(I_FFN_GU, (size_t)f * 1024 * 2 * FF, 2 * FF, 1024, 2 * FF, W_FFN_GU(f), 0, 1, FF, 1.f, 0);
        add(I_FFN_DN, (size_t)f * FF * 1024, 1024, FF, 1024, W_FFN_DN(f), 0, 0, 0, 1.f, 0);
    }
    for (int f = 0; f < 2; ++f)
        for (int e = 0; e < NEXP; ++e) {
            add(I_MOE_GU, ((size_t)f * NEXP + e) * 1024 * 2 * EFF, 2 * EFF, 1024, 2 * EFF, W_MOE_GU(f) + e * MOE_GU_SZ, 0, 1, EFF, 1.f, 0);
            add(I_MOE_DN, ((size_t)f * NEXP + e) * EFF * 1024, 1024, EFF, 1024, W_MOE_DN(f) + e * MOE_DN_SZ, 0, 0, 0, 1.f, 0);
        }
    t.n = n; t.total = items; return t;
}
__device__ const WTab g_wtab = make_wtab();
static_assert(make_wtab().n == N_WDESC, "descriptor count");

struct Params { const float* in[N_IN]; float* out; unsigned char* ws; int ph_lo, ph_hi; };

__device__ __forceinline__ void tr_item(const float* W, const WDesc& d, bf16* WT, LAS float* scr, int item, int lane) {
    const int nblk = d.N / 32, kb = item / nblk, nb = item - kb * nblk, k0 = 64 * kb, n0 = 32 * nb;
    const float sc = (n0 < d.scale_cols) ? d.scale : 1.0f;
#pragma unroll 8
    for (int i = 0; i < 32; ++i) { const int kk = 2 * i + (lane >> 5); scr[kk * 33 + (lane & 31)] = W[(size_t)(k0 + kk) * d.ldw + n0 + (lane & 31)] * sc; }
    LDS_WAIT(); asm volatile("" ::: "memory");
    const int c = lane & 7;
#pragma unroll
    for (int j = 0; j < 4; ++j) { const int n = (lane >> 3) + 8 * j; const LAS float* s = scr + (8 * c) * 33 + n;
        const int ng = n0 + n; int row;
        if (d.mode == 0) row = d.row_off + ng;
        else { const int up = ng >= d.F ? 1 : 0; const int jj = ng - up * d.F; row = (jj >> 7) * 256 + up * 128 + (jj & 127); }
        u32x4 o; o.x = cvt_pk_bf16(s[0 * 33], s[1 * 33]); o.y = cvt_pk_bf16(s[2 * 33], s[3 * 33]); o.z = cvt_pk_bf16(s[4 * 33], s[5 * 33]); o.w = cvt_pk_bf16(s[6 * 33], s[7 * 33]);
        *(GAS u32x4*)(WT + (size_t)row * d.K + k0 + 8 * c) = o; }
    LDS_WAIT(); asm volatile("" ::: "memory");
}

__device__ __forceinline__ void p0_prologue(const Params& P, LAS unsigned char* lds, int tid, int lane, int wave, int G) {
    unsigned char* ws = P.ws;
    float* MOD = (float*)(ws + WS_MOD);
    LAS float* sS = (LAS float*)(lds + RING_OFF); LAS float* red = (LAS float*)(lds + RING_OFF + 36864);
    for (int i = tid; i < 9 * 1024; i += 512) { const float v = (i < 8192) ? P.in[I_C][i] : P.in[I_CCTX][i - 8192]; sS[i] = v * fast_rcp(1.0f + fast_exp2(-v * LOG2E)); }
    __syncthreads();
    for (int it = blockIdx.x; it < 4 * 96; it += G) {
        const int l = it / 96, cc = it - l * 96; const float* wp = P.in[I_ADAW] + ((size_t)l * 1024 + 128 * wave) * 6144 + cc * 64 + lane;
        float a[9];
#pragma unroll
        for (int r = 0; r < 9; ++r) a[r] = 0.f;
#pragma unroll 8
        for (int k = 0; k < 128; ++k) { const float wv = wp[(size_t)k * 6144];
#pragma unroll
            for (int r = 0; r < 9; ++r) a[r] += sS[r * 1024 + 128 * wave + k] * wv; }
#pragma unroll
        for (int r = 0; r < 9; ++r) red[(wave * 9 + r) * 64 + lane] = a[r];
        __syncthreads();
        for (int o = tid; o < 9 * 64; o += 512) { const int r = o >> 6, cl = o & 63; float s = P.in[I_ADAB][l * 6144 + cc * 64 + cl];
#pragma unroll
            for (int w = 0; w < 8; ++w) s += red[(w * 9 + r) * 64 + cl];
            MOD[((size_t)l * 9 + r) * 6144 + cc * 64 + cl] = s; }
        __syncthreads();
    }
    bf16* Wb = (bf16*)(ws + WS_W);
    LAS float* scr = (LAS float*)(lds + RING_OFF + wave * 16384);
    const int gw = blockIdx.x * 8 + wave, NGW = G * 8;
    const int total = g_wtab.total;
    int di = 0;
    for (int it = gw; it < total; it += NGW) {
        while (di + 1 < N_WDESC && g_wtab.d[di + 1].item0 <= it) ++di;
        const WDesc d = g_wtab.d[di];
        tr_item(P.in[d.in_idx] + d.src_off, d, Wb + d.dst_off, scr, it - d.item0, lane);
    }
    for (int i = gw * 64 + lane; i < 2 * 96 * 128; i += NGW * 64) { const int j = i / (96 * 128), r = i - j * 96 * 128; *(GAS u32x4*)(Wb + W_MLA_D(j) + (size_t)672 * 1024 + (size_t)r * 8) = (u32x4){0u, 0u, 0u, 0u}; }
}

struct RowVec { f32x4 v[4]; };
__device__ __forceinline__ void ld_row_f32(RowVec& r, const float* p, int lane) {
#pragma unroll
    for (int j = 0; j < 4; ++j) r.v[j] = *(const f32x4*)(p + 4 * lane + 256 * j);
}
__device__ __forceinline__ void moe_setup(volatile LAS unsigned* misc, gu32* cntw, int tid) {
    if (tid == 0) {
        unsigned p = 0;
        for (int e = 0; e < NEXP; ++e) { const unsigned c = __hip_atomic_load(cntw + 64 * e, RLX_AGENT); const unsigned np = (c + 255u) >> 8;
            misc[MW_CNT + e] = c; misc[MW_OFF + e] = p * 256u;
            for (unsigned lp = 0; lp < np; ++lp) misc[MW_TAB + p + lp] = ((unsigned)e << 16) | lp;
            p += np; }
        misc[MW_NP] = p;
    }
    __syncthreads();
}

template <bool SRC_IN, bool COMBINE, bool OUT_H, bool ROUTER, bool FINAL>
__device__ __forceinline__ void row_phase(const Params& P, LAS unsigned char* lds, volatile LAS unsigned* misc, int tid, int lane, int wave, int G, bool latent_only,
                                          const float* gn, const float* modA, int shift_idx, const float* modG, int moe_f_comb, int moe_f_route) {
    unsigned char* ws = P.ws;
    float* X = (float*)(ws + WS_X); bf16* H = (bf16*)(ws + WS_H); const bf16* YS = (const bf16*)(ws + WS_S + S_YS);
    int* INFO = (int*)(ws + WS_INFO);
    gu32* ctl = (gu32*)(ws + WS_CTL);
    LAS float* rwT = (LAS float*)(lds + RING_OFF);
    if (COMBINE) moe_setup(misc, ctl + CW_CNT + moe_f_comb * 1024, tid);
    if (ROUTER) { const float* rw = P.in[I_MOE_RW] + (size_t)moe_f_route * 1024 * 8;
        for (int i = tid; i < 8192; i += 512) rwT[(i & 7) * 1024 + (i >> 3)] = rw[i];
        __syncthreads(); }
    RowVec g; ld_row_f32(g, gn, lane);
    RowVec sh, scl, gt; int cur_mi = -1;
    const int gw = blockIdx.x * 8 + wave, NGW = G * 8;
    for (int ch = gw; ch < T / 9; ch += NGW) {
        for (int rI = 0; rI < 9; ++rI) {
            const int row = ch * 9 + rI; const int b = row / RPB, rr = row - b * RPB; const bool isctx = rr < CTXL;
            if (latent_only && isctx) continue;
            const int mi = isctx ? 8 : b;
            if (mi != cur_mi) { cur_mi = mi;
                if (OUT_H) { ld_row_f32(sh, modA + ((size_t)mi * 6 + shift_idx) * 1024, lane); ld_row_f32(scl, modA + ((size_t)mi * 6 + shift_idx + 1) * 1024, lane); }
                if (COMBINE) ld_row_f32(gt, modG + ((size_t)mi * 6 + 5) * 1024, lane); }
            RowVec x;
            if (SRC_IN) { const float* src = isctx ? P.in[I_CTX] + ((size_t)b * CTXL + rr) * DM : P.in[I_X] + ((size_t)b * SEQ + (rr - CTXL)) * DM; ld_row_f32(x, src, lane); }
            else ld_row_f32(x, X + (size_t)row * DM, lane);
            if (COMBINE) {
                const i32x4 ia = *(const i32x4*)(INFO + (size_t)row * 8), ib = *(const i32x4*)(INFO + (size_t)row * 8 + 4);
                const int sa = (int)misc[MW_OFF + ia.x] + ia.y, sb = (int)misc[MW_OFF + ib.x] + ib.y; const float wa = __int_as_float(ia.z), wb = __int_as_float(ib.z);
                const bf16* ya = YS + (size_t)sa * DM + 4 * lane; const bf16* yb = YS + (size_t)sb * DM + 4 * lane;
#pragma unroll
                for (int j = 0; j < 4; ++j) { const u32x2 a = *(const u32x2*)(ya + 256 * j), c = *(const u32x2*)(yb + 256 * j);
                    f32x4 y; y.x = wa * bf_lo(a.x) + wb * bf_lo(c.x); y.y = wa * bf_hi(a.x) + wb * bf_hi(c.x); y.z = wa * bf_lo(a.y) + wb * bf_lo(c.y); y.w = wa * bf_hi(a.y) + wb * bf_hi(c.y);
                    x.v[j] = x.v[j] + gt.v[j] * y; }
            }
            if (SRC_IN || COMBINE) {
#pragma unroll
                for (int j = 0; j < 4; ++j) *(f32x4*)(X + (size_t)row * DM + 4 * lane + 256 * j) = x.v[j]; }
            float ss = 0.f;
#pragma unroll
            for (int j = 0; j < 4; ++j) ss += (x.v[j].x * x.v[j].x + x.v[j].y * x.v[j].y) + (x.v[j].z * x.v[j].z + x.v[j].w * x.v[j].w);
            const float rstd = 1.0f / sqrtf(wave_sum(ss) * (1.0f / DM) + NORM_EPS);
            if (FINAL) { if (!isctx) { float* op = P.out + ((size_t)b * SEQ + (rr - CTXL)) * DM + 4 * lane;
#pragma unroll
                    for (int j = 0; j < 4; ++j) *(f32x4*)(op + 256 * j) = x.v[j] * rstd * g.v[j]; } }
            if (OUT_H) {
                RowVec h;
#pragma unroll
                for (int j = 0; j < 4; ++j) { h.v[j] = (x.v[j] * rstd * g.v[j]) * (1.0f + scl.v[j]) + sh.v[j];
                    u32x2 w; w.x = cvt_pk_bf16(h.v[j].x, h.v[j].y); w.y = cvt_pk_bf16(h.v[j].z, h.v[j].w); *(u32x2*)(H + (size_t)row * DM + 4 * lane + 256 * j) = w; }
                if (ROUTER) {
                    float lg[NEXP];
#pragma unroll
                    for (int e = 0; e < NEXP; ++e) { float s = 0.f;
#pragma unroll
                        for (int j = 0; j < 4; ++j) { const f32x4 w = *(const LAS f32x4*)(rwT + e * 1024 + 4 * lane + 256 * j); s += (h.v[j].x * w.x + h.v[j].y * w.y) + (h.v[j].z * w.z + h.v[j].w * w.w); }
                        lg[e] = wave_sum(s) + P.in[I_MOE_RB][moe_f_route * NEXP + e]; }
                    int i1 = 0; float v1 = lg[0];
#pragma unroll
                    for (int e = 1; e < NEXP; ++e) if (lg[e] > v1) { v1 = lg[e]; i1 = e; }
                    int i2 = -1; float v2 = -3.0e38f;
#pragma unroll
                    for (int e = 0; e < NEXP; ++e) if (e != i1 && lg[e] > v2) { v2 = lg[e]; i2 = e; }
                    const float ex = fast_exp2((v2 - v1) * LOG2E); const float w1 = 1.0f / (1.0f + ex), w2 = ex * w1;
                    if (lane == 0) {
                        gu32* cw = ctl + CW_CNT + moe_f_route * 1024; int* LIST = (int*)(ws + WS_LIST) + (size_t)moe_f_route * NEXP * T;
                        const unsigned p1 = __hip_atomic_fetch_add(cw + 64 * i1, 1u, RLX_AGENT), p2 = __hip_atomic_fetch_add(cw + 64 * i2, 1u, RLX_AGENT);
                        LIST[(size_t)i1 * T + p1] = row; LIST[(size_t)i2 * T + p2] = row;
                        *(i32x4*)(INFO + (size_t)row * 8) = (i32x4){i1, (int)p1, __float_as_int(w1), 0}; *(i32x4*)(INFO + (size_t)row * 8 + 4) = (i32x4){i2, (int)p2, __float_as_int(w2), 0};
                    }
                }
            }
        }
    }
}

__device__ __forceinline__ void mla_mid_phase(const Params& P, int lane, int wave, int G, int jm) {
    unsigned char* ws = P.ws;
    const bf16* DOWN = (const bf16*)(ws + WS_S + S_DOWN); bf16* QN = (bf16*)(ws + WS_S + S_QN); bf16* CKV = (bf16*)(ws + WS_S + S_CKV); bf16* KR = (bf16*)(ws + WS_S + S_KR);
    const float* gq = P.in[I_MLA_QNG] + jm * 384; const float* gk = P.in[I_MLA_KVNG] + jm * 256;
    float gqv[6]; f32x4 gkv;
#pragma unroll
    for (int j = 0; j < 3; ++j) { gqv[2 * j] = gq[2 * lane + 128 * j]; gqv[2 * j + 1] = gq[2 * lane + 128 * j + 1]; }
    gkv = *(const f32x4*)(gk + 4 * lane);
    const int gw = blockIdx.x * 8 + wave, NGW = G * 8;
    for (int row = gw; row < T; row += NGW) {
        const int b = row / RPB, rr = row - b * RPB; const bool isctx = rr < CTXL;
        const bf16* dr = DOWN + (size_t)row * 768;
        float q[6]; float ss = 0.f;
#pragma unroll
        for (int j = 0; j < 3; ++j) { const unsigned u = *(const unsigned*)(dr + 2 * lane + 128 * j); q[2 * j] = bf_lo(u); q[2 * j + 1] = bf_hi(u); ss += q[2 * j] * q[2 * j] + q[2 * j + 1] * q[2 * j + 1]; }
        const float rq = 1.0f / sqrtf(wave_sum(ss) * (1.0f / 384.0f) + NORM_EPS);
#pragma unroll
        for (int j = 0; j < 3; ++j) *(unsigned*)(QN + (size_t)row * 384 + 2 * lane + 128 * j) = cvt_pk_bf16(q[2 * j] * rq * gqv[2 * j], q[2 * j + 1] * rq * gqv[2 * j + 1]);
        const u32x2 cu = *(const u32x2*)(dr + 384 + 4 * lane);
        const float c0 = bf_lo(cu.x), c1 = bf_hi(cu.x), c2 = bf_lo(cu.y), c3 = bf_hi(cu.y);
        const float rc = 1.0f / sqrtf(wave_sum((c0 * c0 + c1 * c1) + (c2 * c2 + c3 * c3)) * (1.0f / 256.0f) + NORM_EPS);
        { u32x2 w; w.x = cvt_pk_bf16(c0 * rc * gkv.x, c1 * rc * gkv.y); w.y = cvt_pk_bf16(c2 * rc * gkv.z, c3 * rc * gkv.w); *(u32x2*)(CKV + (size_t)row * 256 + 4 * lane) = w; }
        if (lane < 16) {
            const float x1 = bf_lo((unsigned)dr[640 + lane]), x2 = bf_lo((unsigned)dr[656 + lane]);
            float o1 = x1, o2 = x2;
            if (!isctx) { const int pos = rr - CTXL; const float pr = (float)(pos >> 6), pc = (float)(pos & 63);
                const float inv = fast_exp2(-(float)(lane & 7) * (13.287712379549449f / 8.0f)); float sn, cs; sincos_rad(((lane < 8) ? pr : pc) * inv, sn, cs);
                o1 = x1 * cs - x2 * sn; o2 = x2 * cs + x1 * sn; }
            KR[(size_t)row * 32 + lane] = (bf16)(cvt_pk_bf16(o1, 0.f) & 0xffffu); KR[(size_t)row * 32 + 16 + lane] = (bf16)(cvt_pk_bf16(o2, 0.f) & 0xffffu);
        }
    }
}

__device__ __forceinline__ void mla_qpost_phase(const Params& P, int lane, int wave, int G) {
    bf16* QM = (bf16*)(P.ws + WS_S + S_QM);
    const int gw = blockIdx.x * 8 + wave, NGW = G * 8; const int hq = lane >> 2, d4 = 4 * (lane & 3);
    float inv[4];
#pragma unroll
    for (int e = 0; e < 4; ++e) inv[e] = fast_exp2(-(float)((d4 + e) & 7) * (13.287712379549449f / 8.0f));
    for (int row = gw; row < T; row += NGW) {
        const int b = row / RPB, rr = row - b * RPB; if (rr < CTXL) continue;
        const int pos = rr - CTXL; const float pr = (float)(pos >> 6), pc = (float)(pos & 63);
        bf16* p1 = QM + (size_t)row * 1536 + hq * 96 + 64 + d4; bf16* p2 = p1 + 16;
        const u32x2 a = *(const u32x2*)p1, c = *(const u32x2*)p2;
        const float x1[4] = {bf_lo(a.x), bf_hi(a.x), bf_lo(a.y), bf_hi(a.y)}, x2[4] = {bf_lo(c.x), bf_hi(c.x), bf_lo(c.y), bf_hi(c.y)};
        float o1[4], o2[4];
#pragma unroll
        for (int e = 0; e < 4; ++e) { float sn, cs; sincos_rad((((d4 + e) < 8) ? pr : pc) * inv[e], sn, cs); o1[e] = x1[e] * cs - x2[e] * sn; o2[e] = x2[e] * cs + x1[e] * sn; }
        u32x2 w1, w2; w1.x = cvt_pk_bf16(o1[0], o1[1]); w1.y = cvt_pk_bf16(o1[2], o1[3]); w2.x = cvt_pk_bf16(o2[0], o2[1]); w2.y = cvt_pk_bf16(o2[2], o2[3]);
        *(u32x2*)p1 = w1; *(u32x2*)p2 = w2;
    }
}

template <bool NORM>
__device__ __forceinline__ void qk_post_phase(const Params& P, int lane, int wave, int G, int ld, int nkv, const float* gqp, const float* gkp, float qscale) {
    bf16* QKV = (bf16*)(P.ws + WS_S + S_QKV);
    const int gw = blockIdx.x * 8 + wave, NGW = G * 8; const int hs = lane >> 3, d4 = 4 * (lane & 7); const int nh = 16 + nkv;
    float inv[4];
#pragma unroll
    for (int e = 0; e < 4; ++e) inv[e] = fast_exp2(-(float)((d4 + e) & 15) * (13.287712379549449f / 16.0f));
    f32x4 gq1 = {1.f, 1.f, 1.f, 1.f}, gq2 = gq1, gk1 = gq1, gk2 = gq1;
    if (NORM) { gq1 = *(const f32x4*)(gqp + d4) * qscale; gq2 = *(const f32x4*)(gqp + 32 + d4) * qscale; gk1 = *(const f32x4*)(gkp + d4); gk2 = *(const f32x4*)(gkp + 32 + d4); }
    for (int row = gw; row < T; row += NGW) {
        const int b = row / RPB, rr = row - b * RPB; const bool isctx = rr < CTXL;
        if (!NORM && isctx) continue;
        const int pos = rr - CTXL; const float pr = (float)(pos >> 6), pc = (float)(pos & 63);
        float sn[4], cs[4];
#pragma unroll
        for (int e = 0; e < 4; ++e) { if (isctx) { sn[e] = 0.f; cs[e] = 1.f; } else sincos_rad((((d4 + e) < 16) ? pr : pc) * inv[e], sn[e], cs[e]); }
        for (int h0 = 0; h0 < nh; h0 += 8) {
            const int hd = h0 + hs; const bool act = hd < nh; const int hh = act ? hd : 0;
            bf16* p1 = QKV + (size_t)row * ld + hh * 64 + d4; bf16* p2 = p1 + 32;
            const u32x2 a = *(const u32x2*)p1, c = *(const u32x2*)p2;
            float x1[4] = {bf_lo(a.x), bf_hi(a.x), bf_lo(a.y), bf_hi(a.y)}, x2[4] = {bf_lo(c.x), bf_hi(c.x), bf_lo(c.y), bf_hi(c.y)};
            if (NORM) { float ss = 0.f;
#pragma unroll
                for (int e = 0; e < 4; ++e) ss += x1[e] * x1[e] + x2[e] * x2[e];
                ss += __shfl_xor(ss, 1); ss += __shfl_xor(ss, 2); ss += __shfl_xor(ss, 4);
                const float rs = 1.0f / sqrtf(ss * (1.0f / 64.0f) + NORM_EPS); const bool isq = hd < 16;
#pragma unroll
                for (int e = 0; e < 4; ++e) { x1[e] *= rs * (isq ? gq1[e] : gk1[e]); x2[e] *= rs * (isq ? gq2[e] : gk2[e]); } }
            float o1[4], o2[4];
#pragma unroll
            for (int e = 0; e < 4; ++e) { o1[e] = x1[e] * cs[e] - x2[e] * sn[e]; o2[e] = x2[e] * cs[e] + x1[e] * sn[e]; }
            if (act) { u32x2 w1, w2; w1.x = cvt_pk_bf16(o1[0], o1[1]); w1.y = cvt_pk_bf16(o1[2], o1[3]); w2.x = cvt_pk_bf16(o2[0], o2[1]); w2.y = cvt_pk_bf16(o2[2], o2[3]);
                *(u32x2*)p1 = w1; *(u32x2*)p2 = w2; }
        }
    }
}

#define XB_TMO      128
#define XB_XCNT(j)  (256  + 64 * (j))
#define XB_XSUB(j)  (1280 + 64 * (j))
#define XB_XGEN(j)  (2304 + 64 * (j))
#define XB_TOP      3328
#define XB_TOPGEN   3392
#define XCD_BAR_WORDS 3456
#define XB_SPIN_CAP (1u << 18)
__device__ __forceinline__ unsigned xb_ld(unsigned* p)              { return __hip_atomic_load(p, __ATOMIC_RELAXED, __HIP_MEMORY_SCOPE_AGENT); }
__device__ __forceinline__ unsigned xb_add(unsigned* p, unsigned v) { return __hip_atomic_fetch_add(p, v, __ATOMIC_RELAXED, __HIP_MEMORY_SCOPE_AGENT); }
__device__ __forceinline__ unsigned xb_xcc_id() { return (unsigned)__builtin_amdgcn_s_getreg((3 << 11) | 20) & 0xFu; }
#define XB_SPIN(cond, bar) do { unsigned _sp = 0; while (cond) { __builtin_amdgcn_s_sleep(1); \
    if ((++_sp & 255u) == 0u) { if (xb_ld(&(bar)[XB_TMO])) break; if (_sp > XB_SPIN_CAP) { atomicAdd(&(bar)[XB_TMO], 1u); break; } } } } while (0)
struct XcdBarrier { unsigned* bar; unsigned x; volatile LAS unsigned* st; };
__device__ __forceinline__ XcdBarrier xcd_barrier_post(unsigned* bar, volatile LAS unsigned* st) {
    XcdBarrier b; b.bar = bar; b.x = xb_xcc_id(); b.st = st;
    if (threadIdx.x == 0) (void)xb_add(&bar[XB_XCNT(b.x)], 1u);
    return b;
}
__device__ __forceinline__ void xcd_barrier_complete(unsigned* bar, unsigned x, unsigned& nloc, unsigned& nx) {
    const unsigned G = gridDim.x * gridDim.y * gridDim.z;
    unsigned sum, cnt, mine, sp = 0u;
    for (;;) {
        sum = 0u; cnt = 0u; mine = 0u;
#pragma unroll
        for (unsigned j = 0; j < 16; ++j) { const unsigned c = xb_ld(&bar[XB_XCNT(j)]); sum += c; cnt += (c > 0u) ? 1u : 0u; mine = (j == x) ? c : mine; }
        if (sum == G) break;
        __builtin_amdgcn_s_sleep(1);
        if ((++sp & 255u) == 0u) { if (xb_ld(&bar[XB_TMO])) break; if (sp > XB_SPIN_CAP) { atomicAdd(&bar[XB_TMO], 1u); break; } }
    }
    nloc = mine > 0u ? mine : 1u; nx = cnt > 0u ? cnt : 1u;
}
__device__ __forceinline__ void xcd_barrier(const XcdBarrier& b) {
    asm volatile("s_waitcnt vmcnt(0)" ::: "memory");
    __syncthreads();
    if (threadIdx.x == 0) {
        unsigned* bar = b.bar;
        __builtin_amdgcn_s_waitcnt(0);
        unsigned nloc = b.st[0], nx = b.st[1];
        if (nloc == 0u) { xcd_barrier_complete(bar, b.x, nloc, nx); b.st[0] = nloc; b.st[1] = nx; }
        const unsigned old = xb_add(&bar[XB_XSUB(b.x)], 1u);
        const unsigned gen = old / nloc;
        if (old + 1u == (gen + 1u) * nloc) {
            __builtin_amdgcn_fence(__ATOMIC_RELEASE, "agent");
            asm volatile("s_waitcnt vmcnt(0)" ::: "memory");
            const unsigned og = xb_add(&bar[XB_TOP], 1u);
            const unsigned tg = og / nx;
            if (og + 1u == (tg + 1u) * nx) xb_add(&bar[XB_TOPGEN], 1u);
            else XB_SPIN(xb_ld(&bar[XB_TOPGEN]) == tg, bar);
            __builtin_amdgcn_fence(__ATOMIC_ACQUIRE, "agent");
            xb_add(&bar[XB_XGEN(b.x)], 1u);
            asm volatile("s_waitcnt vmcnt(0)" ::: "memory");
        } else {
            XB_SPIN(xb_ld(&bar[XB_XGEN(b.x)]) == gen, bar);
            __builtin_amdgcn_fence(__ATOMIC_ACQUIRE, "agent");
            asm volatile("s_waitcnt vmcnt(0)" ::: "memory");
        }
    }
    __syncthreads();
}

template <int KIND>
__device__ __forceinline__ void attn_phase(const Params& P, LAS unsigned char* lds, int vcu, int G, bool need_ctx) {
    unsigned char* ws = P.ws; bf16* O = (bf16*)(ws + WS_O);
    const int nun = 1024 + (need_ctx ? 128 : 0);
    for (int idx = vcu; idx < nun; idx += G) {
        int bh, qb; if (idx < 1024) { bh = idx >> 3; qb = 1 + (idx & 7); } else { bh = idx - 1024; qb = 0; }
        const int b = bh >> 4, hq = bh & 15; const long r0 = (long)b * RPB;
        if (KIND == 0) { const bf16* QM = (const bf16*)(ws + WS_S + S_QM); const bf16* KVM = (const bf16*)(ws + WS_S + S_KVM); const bf16* KR = (const bf16*)(ws + WS_S + S_KR);
            att::attn_unit<96, 0, 0>(QM + r0 * 1536 + hq * 96, 1536, KVM + r0 * 2048 + hq * 128, 2048, KR + r0 * 32, 32, KVM + r0 * 2048 + hq * 128 + 64, 2048, O + r0 * 1024 + hq * 64, 1024, qb, 0.f, (LAS char*)(lds + RING_OFF)); }
        else if (KIND == 1) { const bf16* QKV = (const bf16*)(ws + WS_S + S_QKV); const int hk = hq >> 2; const float sk = P.in[I_SWA_SINK][hq] * LOG2E;
            att::attn_unit<64, 1, 1>(QKV + r0 * 1536 + hq * 64, 1536, QKV + r0 * 1536 + 1024 + hk * 64, 1536, nullptr, 0, QKV + r0 * 1536 + 1280 + hk * 64, 1536, O + r0 * 1024 + hq * 64, 1024, qb, sk, (LAS char*)(lds + RING_OFF)); }
        else { const bf16* QKV = (const bf16*)(ws + WS_S + S_QKV); const int hk = hq >> 1;
            att::attn_unit<64, 0, 0>(QKV + r0 * 2048 + hq * 64, 2048, QKV + r0 * 2048 + 1024 + hk * 64, 2048, nullptr, 0, QKV + r0 * 2048 + 1536 + hk * 64, 2048, O + r0 * 1024 + hq * 64, 1024, qb, 0.f, (LAS char*)(lds + RING_OFF)); }
    }
}

constexpr int N_PHASES = 38;
__global__ void __launch_bounds__(512, 2) mk_fwd(Params P) {
    extern __shared__ __attribute__((aligned(16))) unsigned char lds_raw[];
    LAS unsigned char* lds = (LAS unsigned char*)lds_raw;
    volatile LAS unsigned* MISC = (volatile LAS unsigned*)(lds + MISC_OFF);
    const int tid = threadIdx.x, lane = tid & 63, wave = __builtin_amdgcn_readfirstlane(tid >> 6);
    const int G = gridDim.x; const int bx = blockIdx.x; const int vcu = (G % 8 == 0) ? (bx % 8) * (G / 8) + bx / 8 : bx;
    unsigned char* ws = P.ws;
    gu32* ctl = (gu32*)(ws + WS_CTL);
    for (int u = tid; u < (LDS_BYTES - MISC_OFF) / 4; u += 512) ((LAS unsigned*)(lds + MISC_OFF))[u] = 0u;
    __syncthreads();
    XcdBarrier bar; bar.bar = (unsigned*)(ctl + CW_BAR); bar.x = 0; bar.st = nullptr;
    if (!MK_SPLIT) bar = xcd_barrier_post((unsigned*)(ctl + CW_BAR), MISC + 8);
    const int lo = P.ph_lo, hi = P.ph_hi;
#define IN(k) (lo <= (k) && (k) < hi)
#define SEAM(k) do { if (IN((k) + 1)) { if (MK_SPLIT) { if (tid == 0) __hip_atomic_store(ctl + CW_TMO, 0xBADBA0u, RLX_AGENT); } else xcd_barrier(bar); } } while (0)
    float* X = (float*)(ws + WS_X); bf16* H = (bf16*)(ws + WS_H); bf16* O = (bf16*)(ws + WS_O); bf16* Wb = (bf16*)(ws + WS_W);
    const float* MOD = (const float*)(ws + WS_MOD);
    bf16* SB = (bf16*)(ws + WS_S);
    bf16* QKV = (bf16*)(ws + WS_S + S_QKV); bf16* DOWN = (bf16*)(ws + WS_S + S_DOWN); bf16* QN = (bf16*)(ws + WS_S + S_QN); bf16* CKV = (bf16*)(ws + WS_S + S_CKV);
    bf16* QM = (bf16*)(ws + WS_S + S_QM); bf16* KVM = (bf16*)(ws + WS_S + S_KVM); bf16* HH = (bf16*)(ws + WS_S + S_HH); bf16* HS = (bf16*)(ws + WS_S + S_HS); bf16* YS = (bf16*)(ws + WS_S + S_YS);
    (void)SB; (void)O;
    const float* NG = P.in[I_NORMG];
    LAS unsigned char* ring = lds + RING_OFF;

#define GEMM_BF16(Aptr, Wptr, Nn, Kk, Optr, ldc_, latonly) do { pg8::Gemm g_{Aptr, Wptr, Nn, Kk}; pg8::DenseOrder S_; S_.init((latonly) ? 64 : NPAN, (Nn) / 256, G, bx, (latonly) ? 1 : 0); \
        pg8::EpiBf16 E_{Optr, ldc_}; pg8::gemm_phase<pg8::EpiBf16, pg8::DenseOrder, false>(ring, g_, S_, E_); } while (0)
#define GEMM_RESID(Aptr, Wptr, Kk, layer, gidx, latonly) do { pg8::Gemm g_{Aptr, Wptr, 1024, Kk}; pg8::DenseOrder S_; S_.init((latonly) ? 64 : NPAN, 4, G, bx, (latonly) ? 1 : 0); \
        pg8::EpiResid E_{X, MOD + (size_t)(layer) * 9 * 6144 + (gidx) * 1024}; pg8::gemm_phase<pg8::EpiResid, pg8::DenseOrder, false>(ring, g_, S_, E_); } while (0)
#define GEMM_SWIGLU(Wptr) do { pg8::Gemm g_{H, Wptr, 2 * FF, 1024}; pg8::DenseOrder S_; S_.init(NPAN, 2 * FF / 256, G, bx, 0); \
        pg8::EpiSwiglu E_{HH, FF}; pg8::gemm_phase<pg8::EpiSwiglu, pg8::DenseOrder, false>(ring, g_, S_, E_); } while (0)
#define MOE_GU(f) do { moe_setup(MISC, ctl + CW_CNT + (f) * 1024, tid); pg8::Gemm g_{H, Wb + W_MOE_GU(f), 2 * EFF, 1024}; \
        pg8::MoeOrder S_{MISC, (const int*)(ws + WS_LIST) + (size_t)(f) * NEXP * T, 2 * EFF / 256, G, bx, 1}; \
        pg8::EpiSwiglu E_{HS, EFF}; pg8::gemm_phase<pg8::EpiSwiglu, pg8::MoeOrder, true>(ring, g_, S_, E_); } while (0)
#define MOE_DN(f) do { moe_setup(MISC, ctl + CW_CNT + (f) * 1024, tid); pg8::Gemm g_{HS, Wb + W_MOE_DN(f), 1024, EFF}; \
        pg8::MoeOrder S_{MISC, (const int*)(ws + WS_LIST) + (size_t)(f) * NEXP * T, 4, G, bx, 0}; \
        pg8::EpiBf16 E_{YS, 1024}; pg8::gemm_phase<pg8::EpiBf16, pg8::MoeOrder, false>(ring, g_, S_, E_); } while (0)

    if (IN(0)) { p0_prologue(P, lds, tid, lane, wave, G); SEAM(0); }
    if (IN(1)) { row_phase<true, false, true, false, false>(P, lds, MISC, tid, lane, wave, G, false, NG + 0 * 2048 + 0, MOD + 0 * 9 * 6144, 0, nullptr, 0, 0); SEAM(1); }
    if (IN(2)) { GEMM_BF16(H, Wb + W_MLA_D(0), 768, 1024, DOWN, 768, false); SEAM(2); }
    if (IN(3)) { mla_mid_phase(P, lane, wave, G, 0); SEAM(3); }
    if (IN(4)) { GEMM_BF16(QN, Wb + W_MLA_UQ(0), 1536, 384, QM, 1536, false); GEMM_BF16(CKV, Wb + W_MLA_UKV(0), 2048, 256, KVM, 2048, false); SEAM(4); }
    if (IN(5)) { mla_qpost_phase(P, lane, wave, G); SEAM(5); }
    if (IN(6)) { attn_phase<0>(P, lds, vcu, G, true); SEAM(6); }
    if (IN(7)) { GEMM_RESID(O, Wb + W_MLA_O(0), 1024, 0, 2, false); SEAM(7); }
    if (IN(8)) { row_phase<false, false, true, false, false>(P, lds, MISC, tid, lane, wave, G, false, NG + 0 * 2048 + 1024, MOD + 0 * 9 * 6144, 3, nullptr, 0, 0); SEAM(8); }
    if (IN(9)) { GEMM_SWIGLU(Wb + W_FFN_GU(0)); SEAM(9); }
    if (IN(10)) { GEMM_RESID(HH, Wb + W_FFN_DN(0), FF, 0, 5, false); SEAM(10); }
    if (IN(11)) { row_phase<false, false, true, false, false>(P, lds, MISC, tid, lane, wave, G, false, NG + 1 * 2048 + 0, MOD + 1 * 9 * 6144, 0, nullptr, 0, 0); SEAM(11); }
    if (IN(12)) { GEMM_BF16(H, Wb + W_SWA_QKV, 1536, 1024, QKV, 1536, false); SEAM(12); }
    if (IN(13)) { qk_post_phase<false>(P, lane, wave, G, 1536, 4, nullptr, nullptr, 1.0f); SEAM(13); }
    if (IN(14)) { attn_phase<1>(P, lds, vcu, G, true); SEAM(14); }
    if (IN(15)) { GEMM_RESID(O, Wb + W_SWA_O, 1024, 1, 2, false); SEAM(15); }
    if (IN(16)) { row_phase<false, false, true, true, false>(P, lds, MISC, tid, lane, wave, G, false, NG + 1 * 2048 + 1024, MOD + 1 * 9 * 6144, 3, nullptr, 0, 0); SEAM(16); }
    if (IN(17)) { MOE_GU(0); SEAM(17); }
    if (IN(18)) { MOE_DN(0); SEAM(18); }
    if (IN(19)) { row_phase<false, true, true, false, false>(P, lds, MISC, tid, lane, wave, G, false, NG + 2 * 2048 + 0, MOD + 2 * 9 * 6144, 0, MOD + 1 * 9 * 6144, 0, 0); SEAM(19); }
    if (IN(20)) { GEMM_BF16(H, Wb + W_GA_QKV, 2048, 1024, QKV, 2048, false); SEAM(20); }
    if (IN(21)) { qk_post_phase<true>(P, lane, wave, G, 2048, 8, P.in[I_GA_QNG], P.in[I_GA_KNG], QS64); SEAM(21); }
    if (IN(22)) { attn_phase<2>(P, lds, vcu, G, true); SEAM(22); }
    if (IN(23)) { GEMM_RESID(O, Wb + W_GA_O, 1024, 2, 2, false); SEAM(23); }
    if (IN(24)) { row_phase<false, false, true, false, false>(P, lds, MISC, tid, lane, wave, G, false, NG + 2 * 2048 + 1024, MOD + 2 * 9 * 6144, 3, nullptr, 0, 0); SEAM(24); }
    if (IN(25)) { GEMM_SWIGLU(Wb + W_FFN_GU(1)); SEAM(25); }
    if (IN(26)) { GEMM_RESID(HH, Wb + W_FFN_DN(1), FF, 2, 5, false); SEAM(26); }
    if (IN(27)) { row_phase<false, false, true, false, false>(P, lds, MISC, tid, lane, wave, G, false, NG + 3 * 2048 + 0, MOD + 3 * 9 * 6144, 0, nullptr, 0, 0); SEAM(27); }
    if (IN(28)) { GEMM_BF16(H, Wb + W_MLA_D(1), 768, 1024, DOWN, 768, false); SEAM(28); }
    if (IN(29)) { mla_mid_phase(P, lane, wave, G, 1); SEAM(29); }
    if (IN(30)) { GEMM_BF16(QN, Wb + W_MLA_UQ(1), 1536, 384, QM, 1536, true); GEMM_BF16(CKV, Wb + W_MLA_UKV(1), 2048, 256, KVM, 2048, false); SEAM(30); }
    if (IN(31)) { mla_qpost_phase(P, lane, wave, G); SEAM(31); }
    if (IN(32)) { attn_phase<0>(P, lds, vcu, G, false); SEAM(32); }
    if (IN(33)) { GEMM_RESID(O, Wb + W_MLA_O(1), 1024, 3, 2, true); SEAM(33); }
    if (IN(34)) { row_phase<false, false, true, true, false>(P, lds, MISC, tid, lane, wave, G, true, NG + 3 * 2048 + 1024, MOD + 3 * 9 * 6144, 3, nullptr, 0, 1); SEAM(34); }
    if (IN(35)) { MOE_GU(1); SEAM(35); }
    if (IN(36)) { MOE_DN(1); SEAM(36); }
    if (IN(37)) { row_phase<false, true, false, false, true>(P, lds, MISC, tid, lane, wave, G, true, P.in[I_FNORMG], nullptr, 0, MOD + 3 * 9 * 6144, 1, 0); }
#undef IN
#undef SEAM
}

extern "C" void kernel_launch(void* const* d_in, const int* in_sizes, int n_in, void* d_out, int out_size, void* d_ws, size_t ws_size, hipStream_t stream) {
    static int grid = 0;
    if (grid == 0) {
        if (n_in != N_IN || in_sizes[0] != NB * SEQ * DM || out_size != NB * SEQ * DM || ws_size < WS_END) {
            fprintf(stderr, "kernel_launch: unexpected problem (n_in %d, in0 %d, out %d, ws %zu); nothing launched\n", n_in, n_in > 0 ? in_sizes[0] : -1, out_size, ws_size); grid = -1; return; }
        int dev = 0, cus = 0, per_cu = 0;
        if (hipGetDevice(&dev) != hipSuccess || hipDeviceGetAttribute(&cus, hipDeviceAttributeMultiprocessorCount, dev) != hipSuccess) { grid = -1; return; }
        if (hipFuncSetAttribute((const void*)mk_fwd, hipFuncAttributeMaxDynamicSharedMemorySize, LDS_BYTES) != hipSuccess) { fprintf(stderr, "kernel_launch: hipFuncSetAttribute failed\n"); grid = -1; return; }
        if (hipOccupancyMaxActiveBlocksPerMultiprocessor(&per_cu, (const void*)mk_fwd, 512, LDS_BYTES) != hipSuccess || per_cu < 1)
            fprintf(stderr, "kernel_launch: note: occupancy query reports %d workgroups per CU\n", per_cu);
        (void)hipGetLastError();
        grid = cus;
    }
    if (grid < 0) return;
    if (hipMemsetAsync((char*)d_ws + WS_CTL, 0, CTL_ZERO_BYTES, stream) != hipSuccess) return;
    Params p{};
    for (int i = 0; i < N_IN; ++i) p.in[i] = (const float*)d_in[i];
    p.out = (float*)d_out; p.ws = (unsigned char*)d_ws;
#if MK_SPLIT
    for (int ph = 0; ph < N_PHASES; ++ph) { p.ph_lo = ph; p.ph_hi = ph + 1; hipLaunchKernelGGL(mk_fwd, dim3(grid), dim3(512), LDS_BYTES, stream, p); }
#else
    p.ph_lo = 0; p.ph_hi = N_PHASES;
    hipLaunchKernelGGL(mk_fwd, dim3(grid), dim3(512), LDS_BYTES, stream, p);
#endif
}
```
